# Optimizing an MI355X kernel written in HIP

```python
import math
import jax, jax.numpy as jnp
from jax import lax
import numpy as np

D_MODEL = 1024
BATCH = 1
SEQ = 16384
DEPTH = 4
DEC_BATCH = 32
DEC_SEQ = 64
PAST_LEN = 2048

CHUNK = 64
D_MIX = D_MODEL
D_B = D_MIX // 4
POOL_WINDOWS = (2, 4, 8, 16)
N_POOL = len(POOL_WINDOWS)
POOL_GROUP = D_B // N_POOL
POOL_BUF = max(POOL_WINDOWS) - 1
HEAD_DIM = 64
N_HEADS_C = 4
D_C = N_HEADS_C * HEAD_DIM
Q_BLOCK = 128
K_BLOCK = 128
D_A = D_MIX - D_B - D_C
LRU_BLOCK = 64
N_LRU_BLOCKS = D_A // LRU_BLOCK
CONV_W = 4
LRU_C = 8.0
D_IN = 2 * D_A + D_B + 3 * D_C
SPLITS = (D_A, 2 * D_A, 2 * D_A + D_B, 2 * D_A + D_B + D_C, 2 * D_A + D_B + 2 * D_C)
D_FF = 256 * (-(-(8 * D_MODEL) // (3 * 256)))
EPS = 1e-6

kernel_name = "hymba_rglru_pool_stickbreaking_stream_step"


def rms_norm(x, g):
    xf = x.astype(jnp.float32)
    y = xf * lax.rsqrt(jnp.mean(xf * xf, axis=-1, keepdims=True) + EPS)
    return (y * g.astype(jnp.float32)).astype(x.dtype)


def causal_conv(x, buf, w, b):
    L = x.shape[1]
    xp = jnp.concatenate([buf, x], axis=1)
    y = b + sum(xp[:, j:j + L] * w[j] for j in range(CONV_W))
    return y, xp[:, -(CONV_W - 1):]


def rg_lru(x, h0, ga_w, ga_b, gx_w, gx_b, lam):
    B, L, _ = x.shape
    xb = x.reshape(B, L, N_LRU_BLOCKS, LRU_BLOCK)
    r = jax.nn.sigmoid(jnp.einsum("blhi,hij->blhj", xb, ga_w) + ga_b).reshape(B, L, D_A)
    i = jax.nn.sigmoid(jnp.einsum("blhi,hij->blhj", xb, gx_w) + gx_b).reshape(B, L, D_A)
    log_a = -LRU_C * r.astype(jnp.float32) * jax.nn.softplus(-lam.astype(jnp.float32))
    a = jnp.exp(log_a)
    u = jnp.sqrt(-jnp.expm1(2.0 * log_a)) * (i.astype(jnp.float32) * x.astype(jnp.float32))

    def combine(left, right):
        a1, b1 = left
        a2, b2 = right
        return a1 * a2, a2 * b1 + b2

    a_cum, b_cum = lax.associative_scan(combine, (a, u), axis=1)
    h = a_cum * h0.astype(jnp.float32)[:, None, :] + b_cum
    return h.astype(x.dtype), h[:, -1].astype(x.dtype)


def multiscale_pool(u, buf, pos0, pool_w, pool_scale):
    B, L, _ = u.shape
    up = jnp.concatenate([buf, u], axis=1).astype(jnp.float32)
    pos = pos0 + jnp.arange(L)
    means = []
    for g, w in enumerate(POOL_WINDOWS):
        sl = slice(g * POOL_GROUP, (g + 1) * POOL_GROUP)
        s = sum(up[:, POOL_BUF - j:POOL_BUF - j + L, sl] for j in range(w))
        cnt = jnp.minimum(pos + 1, w).astype(jnp.float32)[None, :, None]
        means.append(s / cnt)
    d = (jnp.concatenate(means, axis=-1) - u.astype(jnp.float32)).reshape(B, L, N_POOL, POOL_GROUP)
    y = jnp.einsum("blgi,gij->blgj", d, pool_w.astype(jnp.float32)).reshape(B, L, D_B)
    y = y * pool_scale.astype(jnp.float32)
    new_buf = jnp.concatenate([buf, u], axis=1)[:, -POOL_BUF:]
    return y.astype(u.dtype), new_buf


def stick_breaking(q, k, v, q_pos, k_pos):
    B, Tq, H, _ = q.shape
    Tk = k.shape[1]
    n_kb = Tk // K_BLOCK
    z = jnp.einsum("bqhd,bkhd->bhqk", q, k, preferred_element_type=jnp.float32)
    mask = k_pos[None, :] < q_pos[:, None]
    nl = jnp.where(mask, jnp.log1p(jnp.exp(z)), 0.0).reshape(B, H, Tq, n_kb, K_BLOCK)
    tri_in = jnp.asarray(np.tril(np.ones((K_BLOCK, K_BLOCK), np.float32)))
    tri_ex = jnp.asarray(np.tril(np.ones((n_kb, n_kb), np.float32), -1))
    within = jnp.einsum("bhqnj,js->bhqns", nl, tri_in)
    later = jnp.einsum("bhqm,mn->bhqn", nl.sum(axis=-1), tri_ex)
    surv = (within + later[..., None]).reshape(B, H, Tq, Tk)
    attn = jnp.where(mask, jnp.exp(z - surv), 0.0)
    return jnp.einsum("bhqk,bkhd->bqhd", attn.astype(v.dtype), v)


def stick_breaking_prompt(q, k, v):
    S = q.shape[1]
    outs = []
    for i in range(S // Q_BLOCK):
        kend = (i + 1) * Q_BLOCK
        q_pos = i * Q_BLOCK + jnp.arange(Q_BLOCK)
        outs.append(stick_breaking(q[:, i * Q_BLOCK:kend], k[:, :kend], v[:, :kend], q_pos, jnp.arange(kend)))
    return jnp.concatenate(outs, axis=1)


def stick_breaking_sample(q, k_past, v_past, k, v, pos0):
    B, L, H, D = q.shape
    tk = k_past.shape[1] + L
    pad = (-tk) % K_BLOCK
    zpad = jnp.zeros((B, pad, H, D), k.dtype)
    kf = jnp.concatenate([k_past, k, zpad], axis=1)
    vf = jnp.concatenate([v_past, v, zpad], axis=1)
    return stick_breaking(q, kf, vf, pos0 + jnp.arange(L), jnp.arange(tk + pad))


def trunk_layer(x, lw, conv_buf, lru_h, pool_buf, k_past, v_past, pos0):
    B, L, _ = x.shape
    h = rms_norm(x, lw["attn_norm"])
    proj = jnp.einsum("bld,de->ble", h, lw["w_in"])
    x_a, g_a, u_b, q, k, v = jnp.split(proj, SPLITS, axis=-1)
    xc, new_conv = causal_conv(x_a, conv_buf, lw["conv_w"], lw["conv_b"])
    y_lru, new_h = rg_lru(xc, lru_h, lw["gate_a_w"], lw["gate_a_b"], lw["gate_x_w"], lw["gate_x_b"], lw["lru_lambda"])
    y_a = y_lru * jax.nn.gelu(g_a, approximate=True)
    y_b, new_pool = multiscale_pool(u_b, pool_buf, pos0, lw["pool_w"], lw["pool_scale"])
    q = rms_norm(q.reshape(B, L, N_HEADS_C, HEAD_DIM), lw["q_norm"]) * (HEAD_DIM ** -0.5)
    k = rms_norm(k.reshape(B, L, N_HEADS_C, HEAD_DIM), lw["k_norm"])
    v = v.reshape(B, L, N_HEADS_C, HEAD_DIM)
    if k_past is None:
        o = stick_breaking_prompt(q, k, v)
    else:
        o = stick_breaking_sample(q, k_past, v_past, k, v, pos0)
    mixed = jnp.concatenate([y_a, y_b, o.reshape(B, L, D_C)], axis=-1)
    x = x + jnp.einsum("ble,ed->bld", mixed, lw["w_out"])
    h2 = rms_norm(x, lw["ffn_norm"])
    ff = jax.nn.silu(h2 @ lw["w_gate"]) * (h2 @ lw["w_up"])
    x = x + ff @ lw["w_down"]
    return x, new_conv, new_h, new_pool, k, v


def setup_inputs(seed: int = 0) -> dict:
    key = jax.random.key(seed)
    ks = jax.random.split(key, 32)
    f32 = jnp.float32
    nrm = lambda k, shape, s: jax.random.normal(k, shape, f32) * s
    out_scale = (2.0 * DEPTH) ** -0.5
    u = jax.random.uniform(ks[14], (DEPTH, D_A), f32, 0.9, 0.999)
    a = u ** (1.0 / LRU_C)
    lru_lambda = jnp.log(a) - jnp.log1p(-a)
    return {
        "x_prompt": nrm(ks[0], (BATCH, SEQ, D_MODEL), 1.0),
        "x_sample": nrm(ks[1], (DEC_BATCH, DEC_SEQ, D_MODEL), 1.0),
        "cache_k": nrm(ks[2], (DEPTH, DEC_BATCH, PAST_LEN, N_HEADS_C, HEAD_DIM), 1.0),
        "cache_v": nrm(ks[3], (DEPTH, DEC_BATCH, PAST_LEN, N_HEADS_C, HEAD_DIM), 1.0),
        "state_conv": nrm(ks[4], (DEPTH, DEC_BATCH, CONV_W - 1, D_A), 1.0),
        "state_lru": nrm(ks[5], (DEPTH, DEC_BATCH, D_A), 0.5),
        "state_pool": nrm(ks[6], (DEPTH, DEC_BATCH, POOL_BUF, D_B), 1.0),
        "attn_norm": 1.0 + nrm(ks[7], (DEPTH, D_MODEL), 0.02),
        "w_in": nrm(ks[8], (DEPTH, D_MODEL, D_IN), D_MODEL ** -0.5),
        "conv_w": nrm(ks[9], (DEPTH, CONV_W, D_A), CONV_W ** -0.5),
        "conv_b": nrm(ks[10], (DEPTH, D_A), 0.01),
        "gate_a_w": nrm(ks[11], (DEPTH, N_LRU_BLOCKS, LRU_BLOCK, LRU_BLOCK), LRU_BLOCK ** -0.5),
        "gate_a_b": nrm(ks[12], (DEPTH, N_LRU_BLOCKS, LRU_BLOCK), 0.01),
        "gate_x_w": nrm(ks[13], (DEPTH, N_LRU_BLOCKS, LRU_BLOCK, LRU_BLOCK), LRU_BLOCK ** -0.5),
        "gate_x_b": nrm(ks[15], (DEPTH, N_LRU_BLOCKS, LRU_BLOCK), 0.01),
        "lru_lambda": lru_lambda,
        "pool_w": nrm(ks[16], (DEPTH, N_POOL, POOL_GROUP, POOL_GROUP), POOL_GROUP ** -0.5),
        "pool_scale": 1.0 + nrm(ks[17], (DEPTH, D_B), 0.02),
        "q_norm": 1.0 + nrm(ks[18], (DEPTH, HEAD_DIM), 0.02),
        "k_norm": 1.0 + nrm(ks[19], (DEPTH, HEAD_DIM), 0.02),
        "w_out": nrm(ks[20], (DEPTH, D_MIX, D_MODEL), D_MIX ** -0.5 * out_scale),
        "ffn_norm": 1.0 + nrm(ks[21], (DEPTH, D_MODEL), 0.02),
        "w_gate": nrm(ks[22], (DEPTH, D_MODEL, D_FF), D_MODEL ** -0.5),
        "w_up": nrm(ks[23], (DEPTH, D_MODEL, D_FF), D_MODEL ** -0.5),
        "w_down": nrm(ks[24], (DEPTH, D_FF, D_MODEL), D_FF ** -0.5 * out_scale),
    }


def reference(x_prompt, x_sample, cache_k, cache_v, state_conv, state_lru, state_pool,
              attn_norm, w_in, conv_w, conv_b, gate_a_w, gate_a_b, gate_x_w, gate_x_b,
              lru_lambda, pool_w, pool_scale, q_norm, k_norm, w_out, ffn_norm,
              w_gate, w_up, w_down):
    xp = x_prompt
    xs = x_sample
    dt = x_prompt.dtype
    kp_l, vp_l, cp_l, hp_l, pp_l = [], [], [], [], []
    ks_l, vs_l, cs_l, hs_l, ps_l = [], [], [], [], []
    for l in range(DEPTH):
        lw = dict(attn_norm=attn_norm[l], w_in=w_in[l], conv_w=conv_w[l], conv_b=conv_b[l],
                  gate_a_w=gate_a_w[l], gate_a_b=gate_a_b[l], gate_x_w=gate_x_w[l], gate_x_b=gate_x_b[l],
                  lru_lambda=lru_lambda[l], pool_w=pool_w[l], pool_scale=pool_scale[l],
                  q_norm=q_norm[l], k_norm=k_norm[l], w_out=w_out[l], ffn_norm=ffn_norm[l],
                  w_gate=w_gate[l], w_up=w_up[l], w_down=w_down[l])
        xp, c_p, h_p, p_p, k_p, v_p = trunk_layer(
            xp, lw,
            jnp.zeros((xp.shape[0], CONV_W - 1, D_A), dt),
            jnp.zeros((xp.shape[0], D_A), dt),
            jnp.zeros((xp.shape[0], POOL_BUF, D_B), dt),
            None, None, 0)
        xs, c_s, h_s, p_s, k_s, v_s = trunk_layer(
            xs, lw, state_conv[l], state_lru[l], state_pool[l], cache_k[l], cache_v[l], PAST_LEN)
        kp_l.append(k_p); vp_l.append(v_p); cp_l.append(c_p); hp_l.append(h_p); pp_l.append(p_p)
        ks_l.append(k_s); vs_l.append(v_s); cs_l.append(c_s); hs_l.append(h_s); ps_l.append(p_s)
    return (xp, xs,
            jnp.stack(kp_l), jnp.stack(vp_l), jnp.stack(cp_l), jnp.stack(hp_l), jnp.stack(pp_l),
            jnp.stack(ks_l), jnp.stack(vs_l), jnp.stack(cs_l), jnp.stack(hs_l), jnp.stack(ps_l))
```

```cpp
#include <hip/hip_runtime.h>
#include <hip/hip_cooperative_groups.h>
#include <cstdio>
#include <cstdint>
namespace cg = cooperative_groups;
__device__ __forceinline__ int fresh_tid() { int t = threadIdx.x; asm volatile("" : "+v"(t)); return t; }
__device__ __forceinline__ int fresh_bid() { int t = blockIdx.x; asm volatile("" : "+s"(t)); return t; }
#define LAS __attribute__((address_space(3)))
#define XB_TMO      128
#define XB_XCNT(j)  (256  + 64 * (j))
#define XB_XSUB(j)  (1280 + 64 * (j))
#define XB_XGEN(j)  (2304 + 64 * (j))
#define XB_TOP      3328
#define XB_TOPGEN   3392
#define XCD_BAR_WORDS 3456
#define XB_SPIN_CAP (1u << 18)

__device__ __forceinline__ unsigned xb_ld(unsigned* p)              { return __hip_atomic_load(p, __ATOMIC_RELAXED, __HIP_MEMORY_SCOPE_AGENT); }
__device__ __forceinline__ unsigned xb_add(unsigned* p, unsigned v) { return __hip_atomic_fetch_add(p, v, __ATOMIC_RELAXED, __HIP_MEMORY_SCOPE_AGENT); }
__device__ __forceinline__ unsigned xb_xcc_id() { return (unsigned)__builtin_amdgcn_s_getreg((3 << 11) | 20) & 0xFu; }
#define XB_SPIN(cond, bar) do { unsigned _sp = 0; while (cond) { __builtin_amdgcn_s_sleep(1); \
    if ((++_sp & 255u) == 0u) { if (xb_ld(&(bar)[XB_TMO])) break; if (_sp > XB_SPIN_CAP) { atomicAdd(&(bar)[XB_TMO], 1u); break; } } } } while (0)

struct XcdBarrier {
    unsigned* bar; unsigned x;
    volatile LAS unsigned* st;
};

__device__ __forceinline__ XcdBarrier xcd_barrier_post(unsigned* bar, volatile LAS unsigned* st) {
    XcdBarrier b; b.bar = bar; b.x = xb_xcc_id(); b.st = st;
    if (threadIdx.x == 0) (void)xb_add(&bar[XB_XCNT(b.x)], 1u);
    return b;
}
__device__ __forceinline__ void xcd_barrier_complete(unsigned* bar, unsigned x, unsigned& nloc, unsigned& nx) {
    const unsigned G = gridDim.x * gridDim.y * gridDim.z;
    unsigned sum, cnt, mine, sp = 0u;
    for (;;) {
        sum = 0u; cnt = 0u; mine = 0u;
#pragma unroll
        for (unsigned j = 0; j < 16; ++j) { const unsigned c = xb_ld(&bar[XB_XCNT(j)]); sum += c; cnt += (c > 0u) ? 1u : 0u; mine = (j == x) ? c : mine; }
        if (sum == G) break;
        __builtin_amdgcn_s_sleep(1);
        if ((++sp & 255u) == 0u) { if (xb_ld(&bar[XB_TMO])) break; if (sp > XB_SPIN_CAP) { atomicAdd(&bar[XB_TMO], 1u); break; } }
    }
    nloc = mine > 0u ? mine : 1u; nx = cnt > 0u ? cnt : 1u;
}

__device__ __forceinline__ void xcd_barrier(const XcdBarrier& b) {
    asm volatile("s_waitcnt vmcnt(0)" ::: "memory");
    __syncthreads();
    if (threadIdx.x == 0) {
        unsigned* bar = b.bar;
        __builtin_amdgcn_s_waitcnt(0);
        unsigned nloc = b.st[0], nx = b.st[1];
        if (nloc == 0u) { xcd_barrier_complete(bar, b.x, nloc, nx); b.st[0] = nloc; b.st[1] = nx; }
        const unsigned old = xb_add(&bar[XB_XSUB(b.x)], 1u);
        const unsigned gen = old / nloc;
        if (old + 1u == (gen + 1u) * nloc) {
            __builtin_amdgcn_fence(__ATOMIC_RELEASE, "agent");
            asm volatile("s_waitcnt vmcnt(0)" ::: "memory");
            const unsigned og = xb_add(&bar[XB_TOP], 1u);
            const unsigned tg = og / nx;
            if (og + 1u == (tg + 1u) * nx) xb_add(&bar[XB_TOPGEN], 1u);
            else XB_SPIN(xb_ld(&bar[XB_TOPGEN]) == tg, bar);
            __builtin_amdgcn_fence(__ATOMIC_ACQUIRE, "agent");
            xb_add(&bar[XB_XGEN(b.x)], 1u);
            asm volatile("s_waitcnt vmcnt(0)" ::: "memory");
        } else {
            XB_SPIN(xb_ld(&bar[XB_XGEN(b.x)]) == gen, bar);
            __builtin_amdgcn_fence(__ATOMIC_ACQUIRE, "agent");
            asm volatile("s_waitcnt vmcnt(0)" ::: "memory");
        }
    }
    __syncthreads();
}
namespace pg8 {
#define PG8_LAS __attribute__((address_space(3)))
typedef unsigned short bf16_t;
typedef short bf16x8 __attribute__((ext_vector_type(8)));
typedef float f32x4 __attribute__((ext_vector_type(4)));
typedef unsigned u32x4 __attribute__((ext_vector_type(4)));
constexpr int BM = 256, BK = 64, HALF = 128, HTB = HALF * BK * 2  , STAGE_BYTES = 8 * HTB, NXCD = 8, WGM = 8;

__host__ __device__ __forceinline__ int lds_byte(int r, int c) { const int st = (r >> 4) * 2 + (c >> 5), rr = r & 15, cc = c & 31, ob = rr * 64 + cc * 2; return st * 1024 + (ob ^ (((ob >> 9) & 1) << 5)); }
__host__ __device__ __forceinline__ void stage_rc(int b, int& R, int& C) { const int st = b / 1024, sb = b % 1024, swz = sb ^ (((sb >> 9) & 1) << 5); R = (st >> 1) * 16 + swz / 64; C = (st & 1) * 32 + (swz % 64) / 2; }
__host__ __device__ __forceinline__ int perm32(int rho) { const int n = rho >> 4, i = rho & 15; return 8 * (i >> 2) + 4 * n + (i & 3); }

struct Unit { int pm, pn; };
struct Gemm { const bf16_t* A; const bf16_t* Bt; int M, N, K; };

struct StaticOrder {
    int nM, nN, nwg, G, c;
    __host__ __device__ void init(int M, int N, int G_, int c_) { nM = M / BM; nN = N / BM; nwg = nM * nN; G = G_; c = c_; }
    __host__ __device__ bool next(int i, Unit& u) const {
        const long L = (long)i * G + c; if (L >= nwg) return false;
        int wgid = (int)L; { const int q = nwg / NXCD, r = nwg % NXCD, xcd = wgid % NXCD, off = wgid / NXCD; wgid = (xcd < r ? xcd * (q + 1) : r * (q + 1) + (xcd - r) * q) + off; }
        const int nig = WGM * nN, gid = wgid / nig, fm = gid * WGM, gsz = (nM - fm) < WGM ? (nM - fm) : WGM;
        u.pm = fm + ((wgid % nig) % gsz); u.pn = (wgid % nig) / gsz; return true;
    }
    __device__ __forceinline__ void a_ready(const Unit&) const {}
    __device__ __forceinline__ void done(const Unit&) const {}
};

__device__ __forceinline__ unsigned cvt_pk_bf16(float lo, float hi) { unsigned r; asm volatile("v_cvt_pk_bf16_f32 %0, %1, %2" : "=v"(r) : "v"(lo), "v"(hi)); return r; }
typedef float f32x2 __attribute__((ext_vector_type(2)));
template <class Epi, class Sched, bool ALIGN_EPI = false, bool SP2 = false>
__device__ __forceinline__ void gemm_phase(PG8_LAS unsigned char* lds, const Gemm g, const Sched& S, const Epi& E) {
    const int tid = fresh_tid(), wid = __builtin_amdgcn_readfirstlane(tid >> 6), lane = tid & 63, wr = wid >> 2, wc = wid & 3, fr = lane & 15, fq = lane >> 4;
    const int K = g.K, nt = K / BK;
    unsigned voffA[2], voffB[2];
#pragma unroll
    for (int i = 0; i < 2; ++i) { int R, C; stage_rc(tid * 16 + i * 8192, R, C); const int Rb = Epi::PERM ? ((R & ~31) + perm32(R & 31)) : R;
        voffA[i] = (unsigned)(R * K + C) * 2u; voffB[i] = (unsigned)(Rb * K + C) * 2u; }
    const size_t kstep = (size_t)(BK * 2);
    const size_t hstep = (size_t)HALF * K * 2;
    const size_t tstep = 2 * hstep;
    const unsigned ldsw = (unsigned)wid * 1024u;
    const int aoff = lds_byte(wr * 64 + fr, fq * 8), boff = lds_byte(wc * 32 + fr, fq * 8);
#define PG8_SA(b, h) (((b) * 2 + (h)) * HTB)
#define PG8_SB(b, h) ((4 + (b) * 2 + (h)) * HTB)
#define PG8_STAGE(bufoff, gbase, voff) do { _Pragma("unroll") for (int _i = 0; _i < 2; ++_i) \
        __builtin_amdgcn_global_load_lds((const unsigned*)((const char*)(gbase) + (voff)[_i]), (PG8_LAS unsigned*)(lds + (bufoff) + ldsw + _i * 8192), 16, 0, 0); } while (0)
#define PG8_LDA(dst, b, h) do { _Pragma("unroll") for (int m = 0; m < 4; ++m) _Pragma("unroll") for (int k = 0; k < 2; ++k) dst[m][k] = *(const PG8_LAS bf16x8*)(lds + PG8_SA(b, h) + aoff + m * 2048 + k * 1024); } while (0)
#define PG8_LDB(dst, b, h) do { _Pragma("unroll") for (int n = 0; n < 2; ++n) _Pragma("unroll") for (int k = 0; k < 2; ++k) dst[n][k] = *(const PG8_LAS bf16x8*)(lds + PG8_SB(b, h) + boff + n * 2048 + k * 1024); } while (0)
#define PG8_MMA(ai, bj, At, Bt) do { __builtin_amdgcn_s_setprio(1); _Pragma("unroll") for (int m = 0; m < 4; ++m) _Pragma("unroll") for (int n = 0; n < 2; ++n) _Pragma("unroll") for (int k = 0; k < 2; ++k) \
        acc[ai][bj][m][n] = __builtin_amdgcn_mfma_f32_16x16x32_bf16(Bt[n][k], At[m][k], acc[ai][bj][m][n], 0, 0, 0); __builtin_amdgcn_s_setprio(0); } while (0)
#define PG8_WAIT_V(n) asm volatile("s_waitcnt vmcnt(" #n ")" ::: "memory")
#define PG8_WAIT_L(n) asm volatile("s_waitcnt lgkmcnt(" #n ")" ::: "memory")
#define PG8_BAR __builtin_amdgcn_s_barrier()
#define PG8_SCHED __builtin_amdgcn_sched_barrier(0)
    Unit cur, nxt; int ui = 0;
    if (!S.next(0, cur)) return;
    f32x4 acc[2][2][4][2];
#pragma unroll
    for (int a = 0; a < 2; ++a)
#pragma unroll
        for (int b = 0; b < 2; ++b)
#pragma unroll
            for (int m = 0; m < 4; ++m)
#pragma unroll
                for (int n = 0; n < 2; ++n) acc[a][b][m][n] = (f32x4){0.f, 0.f, 0.f, 0.f};
    bf16x8 At[4][2], B0[2][2], B1[2][2];
    const char* cA = (const char*)g.A + (size_t)cur.pm * tstep; const char* cB = (const char*)g.Bt + (size_t)cur.pn * tstep;
    S.a_ready(cur);
    if constexpr (SP2) {
        PG8_STAGE(PG8_SB(0, 0), cB, voffB); PG8_STAGE(PG8_SB(0, 1), cB + hstep, voffB); PG8_STAGE(PG8_SA(0, 0), cA, voffA); PG8_STAGE(PG8_SA(0, 1), cA + hstep, voffA);
        if (wr == 1) PG8_BAR;
        PG8_WAIT_V(2); PG8_BAR;
        PG8_STAGE(PG8_SB(1, 0), cB + kstep, voffB); PG8_STAGE(PG8_SA(1, 0), cA + kstep, voffA); PG8_STAGE(PG8_SB(1, 1), cB + hstep + kstep, voffB);
        PG8_WAIT_V(6); PG8_BAR;
    } else {
        PG8_STAGE(PG8_SB(0, 0), cB, voffB); PG8_STAGE(PG8_SA(0, 0), cA, voffA); PG8_STAGE(PG8_SB(0, 1), cB + hstep, voffB); PG8_STAGE(PG8_SA(0, 1), cA + hstep, voffA);
        if (wr == 1) PG8_BAR;
        PG8_WAIT_V(4); PG8_BAR;
        PG8_STAGE(PG8_SB(1, 0), cB + kstep, voffB); PG8_STAGE(PG8_SA(1, 0), cA + kstep, voffA); PG8_STAGE(PG8_SB(1, 1), cB + hstep + kstep, voffB);
        PG8_WAIT_V(6); PG8_BAR;
    }
    for (;;) {
        const bool has_next = S.next(ui + 1, nxt);
        const char* nA = has_next ? (const char*)g.A + (size_t)nxt.pm * tstep : cA; const char* nB = has_next ? (const char*)g.Bt + (size_t)nxt.pn * tstep : cB;
        for (int t = 0; t < nt; t += 2) {
            const bool last = (t == nt - 2);
            const char* a1 = cA + (size_t)(t + 1) * kstep;
            const char* a2 = last ? nA : cA + (size_t)(t + 2) * kstep; const char* b2 = last ? nB : cB + (size_t)(t + 2) * kstep;
            const char* a3 = a2 + kstep; const char* b3 = b2 + kstep;
            if (last && has_next) S.a_ready(nxt);
            if constexpr (SP2) {
            PG8_LDB(B0, 0, 0); PG8_LDB(B1, 0, 1); PG8_SCHED; PG8_LDA(At, 0, 0); PG8_STAGE(PG8_SA(1, 1), a1 + hstep, voffA);
            PG8_WAIT_V(8); PG8_WAIT_L(0); PG8_BAR; PG8_MMA(0, 0, At, B0); PG8_MMA(0, 1, At, B1); PG8_BAR; PG8_SCHED;
            PG8_LDA(At, 0, 1); PG8_STAGE(PG8_SB(0, 0), b2, voffB); PG8_STAGE(PG8_SB(0, 1), b2 + hstep, voffB); PG8_STAGE(PG8_SA(0, 0), a2, voffA);
            PG8_WAIT_V(8); PG8_WAIT_L(0); PG8_BAR; PG8_MMA(1, 0, At, B0); PG8_MMA(1, 1, At, B1); PG8_BAR; PG8_SCHED;
            PG8_LDB(B0, 1, 0); PG8_LDB(B1, 1, 1); PG8_SCHED; PG8_LDA(At, 1, 0); PG8_STAGE(PG8_SA(0, 1), a2 + hstep, voffA);
            PG8_WAIT_V(8); PG8_WAIT_L(0); PG8_BAR; PG8_MMA(0, 0, At, B0); PG8_MMA(0, 1, At, B1); PG8_BAR; PG8_SCHED;
            PG8_LDA(At, 1, 1); PG8_STAGE(PG8_SB(1, 0), b3, voffB); PG8_STAGE(PG8_SB(1, 1), b3 + hstep, voffB); PG8_STAGE(PG8_SA(1, 0), a3, voffA);
            PG8_WAIT_V(8); PG8_WAIT_L(0); PG8_BAR; PG8_MMA(1, 0, At, B0); PG8_MMA(1, 1, At, B1); PG8_BAR; PG8_SCHED;
            } else {
            PG8_LDB(B0, 0, 0); PG8_SCHED; PG8_LDA(At, 0, 0); PG8_STAGE(PG8_SA(1, 1), a1 + hstep, voffA);
            PG8_WAIT_L(8); PG8_BAR; PG8_WAIT_L(0); PG8_MMA(0, 0, At, B0); PG8_BAR; PG8_SCHED;
            PG8_LDB(B1, 0, 1); PG8_STAGE(PG8_SB(0, 0), b2, voffB);
            PG8_BAR; PG8_WAIT_L(0); PG8_MMA(0, 1, At, B1); PG8_BAR;
            PG8_LDA(At, 0, 1); PG8_STAGE(PG8_SA(0, 0), a2, voffA);
            PG8_BAR; PG8_WAIT_L(0); PG8_MMA(1, 0, At, B0); PG8_BAR; PG8_SCHED;
            PG8_STAGE(PG8_SB(0, 1), b2 + hstep, voffB);
            PG8_WAIT_V(6); PG8_BAR; PG8_MMA(1, 1, At, B1); PG8_BAR;
            PG8_LDB(B0, 1, 0); PG8_SCHED; PG8_LDA(At, 1, 0); PG8_STAGE(PG8_SA(0, 1), a2 + hstep, voffA);
            PG8_WAIT_L(8); PG8_BAR; PG8_WAIT_L(0); PG8_MMA(0, 0, At, B0); PG8_BAR; PG8_SCHED;
            PG8_LDB(B1, 1, 1); PG8_STAGE(PG8_SB(1, 0), b3, voffB);
            PG8_BAR; PG8_WAIT_L(0); PG8_MMA(0, 1, At, B1); PG8_BAR;
            PG8_LDA(At, 1, 1); PG8_STAGE(PG8_SA(1, 0), a3, voffA);
            PG8_BAR; PG8_WAIT_L(0); PG8_MMA(1, 0, At, B0); PG8_BAR; PG8_SCHED;
            PG8_STAGE(PG8_SB(1, 1), b3 + hstep, voffB);
            PG8_WAIT_V(6); PG8_BAR; PG8_MMA(1, 1, At, B1); PG8_BAR;
            }
        }
        if constexpr (ALIGN_EPI) { if (wr == 0) PG8_BAR; }
        if constexpr (!Epi::AFTER_DRAIN) { E(acc, cur, wr, wc, fr, fq); S.done(cur); }
        if (!has_next) break;
#pragma unroll
        for (int a = 0; a < 2; ++a)
#pragma unroll
            for (int b = 0; b < 2; ++b)
#pragma unroll
                for (int m = 0; m < 4; ++m)
#pragma unroll
                    for (int n = 0; n < 2; ++n) acc[a][b][m][n] = (f32x4){0.f, 0.f, 0.f, 0.f};
        cur = nxt; cA = nA; cB = nB; ++ui;
        if constexpr (ALIGN_EPI) { if (wr == 1) PG8_BAR; }
    }
    PG8_WAIT_V(0);
    if constexpr (!ALIGN_EPI) { if (wr == 0) PG8_BAR; }
    PG8_BAR;
    if constexpr (Epi::AFTER_DRAIN) { E.fused(acc, cur, wr, wc, fr, fq, lds, wid, lane); S.done(cur); }
#undef PG8_SA
#undef PG8_SB
#undef PG8_STAGE
#undef PG8_LDA
#undef PG8_LDB
#undef PG8_MMA
#undef PG8_WAIT_V
#undef PG8_WAIT_L
#undef PG8_BAR
#undef PG8_SCHED
}
}
namespace pg8 {
typedef __bf16 bf16x2_t __attribute__((ext_vector_type(2)));
__device__ __forceinline__ unsigned pkbf(float lo, float hi) { f32x2 v = {lo, hi}; bf16x2_t b = __builtin_convertvector(v, bf16x2_t); return __builtin_bit_cast(unsigned, b); }
typedef unsigned u32x2 __attribute__((ext_vector_type(2)));

struct EpiProj {
    static constexpr bool PERM = true, AFTER_DRAIN = false;
    bf16_t* O; int ldc; const float* ss;
    __device__ __forceinline__ void operator()(const f32x4 (&acc)[2][2][4][2], const Unit& u, int wr, int wc, int fr, int fq) const {
        const int row0 = u.pm * BM + wr * 64 + fr; const int col0 = u.pn * BM + wc * 32 + 8 * fq;
#pragma unroll
        for (int ai = 0; ai < 2; ++ai) {
            f32x4 sq[4];
#pragma unroll
            for (int m = 0; m < 4; ++m) sq[m] = ((const f32x4*)(ss + (size_t)(row0 + ai * HALF + m * 16) * 16))[fq];
#pragma unroll
            for (int m = 0; m < 4; ++m) {
                const int row = row0 + ai * HALF + m * 16;
                float st_ = (sq[m][0] + sq[m][1]) + (sq[m][2] + sq[m][3]); st_ += __shfl_xor(st_, 16); st_ += __shfl_xor(st_, 32);
                const float rs = rsqrtf(st_ * (1.0f / 1024.0f) + 1e-6f);
                bf16_t* rowp = O + (size_t)row * ldc + col0;
#pragma unroll
                for (int bj = 0; bj < 2; ++bj) {
                    const f32x4 v0 = acc[ai][bj][m][0] * rs, v1 = acc[ai][bj][m][1] * rs;
                    u32x4 w; w.x = pkbf(v0[0], v0[1]); w.y = pkbf(v0[2], v0[3]); w.z = pkbf(v1[0], v1[1]); w.w = pkbf(v1[2], v1[3]);
                    *(u32x4*)(rowp + bj * HALF) = w;
                }
            }
            asm volatile("" ::: "memory");
        }
    }
};

struct EpiSwiglu {
    static constexpr bool PERM = true, AFTER_DRAIN = false;
    bf16_t* O; int ldc; const float* ss;
    __device__ __forceinline__ void operator()(const f32x4 (&acc)[2][2][4][2], const Unit& u, int wr, int wc, int fr, int fq) const {
        const int row0 = u.pm * BM + wr * 64 + fr; const int col0 = u.pn * HALF + wc * 32 + 8 * fq;
#pragma unroll
        for (int ai = 0; ai < 2; ++ai) {
            f32x4 sq[4];
#pragma unroll
            for (int m = 0; m < 4; ++m) sq[m] = ((const f32x4*)(ss + (size_t)(row0 + ai * HALF + m * 16) * 16))[fq];
#pragma unroll
            for (int m = 0; m < 4; ++m) {
                const int row = row0 + ai * HALF + m * 16;
                float st_ = (sq[m][0] + sq[m][1]) + (sq[m][2] + sq[m][3]); st_ += __shfl_xor(st_, 16); st_ += __shfl_xor(st_, 32);
                const float rs = rsqrtf(st_ * (1.0f / 1024.0f) + 1e-6f);
                float o[8];
#pragma unroll
                for (int n = 0; n < 2; ++n)
#pragma unroll
                    for (int i = 0; i < 4; ++i) {
                        const float g = acc[ai][0][m][n][i] * rs, up = acc[ai][1][m][n][i] * rs;
                        const float sg = g * __builtin_amdgcn_rcpf(1.0f + __expf(-g));
                        o[4 * n + i] = sg * up;
                    }
                u32x4 w; w.x = pkbf(o[0], o[1]); w.y = pkbf(o[2], o[3]); w.z = pkbf(o[4], o[5]); w.w = pkbf(o[6], o[7]);
                *(u32x4*)(O + (size_t)row * ldc + col0) = w;
            }
            asm volatile("" ::: "memory");
        }
    }
};

template <bool RESF32, bool OUTF32> struct EpiRes {
    static constexpr bool PERM = true, AFTER_DRAIN = false;
    const float* resA; const float* resB; int splitRow;
    float* X; bf16_t* XN; float* ssout;
    __device__ __forceinline__ void operator()(const f32x4 (&acc)[2][2][4][2], const Unit& u, int wr, int wc, int fr, int fq) const {
        const int col0 = u.pn * BM + wc * 32 + 8 * fq;
        const int trow = u.pm * BM;
        const float* rbase = nullptr;
        if constexpr (RESF32) rbase = (trow < splitRow) ? (resA + (size_t)trow * 1024) : (resB + (size_t)(trow - splitRow) * 1024);
#pragma unroll
        for (int ai = 0; ai < 2; ++ai)
#pragma unroll
            for (int m = 0; m < 4; ++m) {
                const int lr = ai * HALF + wr * 64 + m * 16 + fr;
                const size_t off = (size_t)(trow + lr) * 1024 + col0;
                float s = 0.f;
#pragma unroll
                for (int bj = 0; bj < 2; ++bj) {
                    f32x4 r0, r1;
                    if constexpr (RESF32) { r0 = *(const f32x4*)(rbase + (size_t)lr * 1024 + col0 + bj * HALF); r1 = *(const f32x4*)(rbase + (size_t)lr * 1024 + col0 + bj * HALF + 4); }
                    else { const u32x4 w = *(const u32x4*)(XN + off + bj * HALF);
                        r0 = (f32x4){__uint_as_float(w.x << 16), __uint_as_float(w.x & 0xffff0000u), __uint_as_float(w.y << 16), __uint_as_float(w.y & 0xffff0000u)};
                        r1 = (f32x4){__uint_as_float(w.z << 16), __uint_as_float(w.z & 0xffff0000u), __uint_as_float(w.w << 16), __uint_as_float(w.w & 0xffff0000u)}; }
                    const f32x4 v0 = r0 + acc[ai][bj][m][0], v1 = r1 + acc[ai][bj][m][1];
                    if constexpr (OUTF32) { __builtin_nontemporal_store(v0, (f32x4*)(X + off + bj * HALF)); __builtin_nontemporal_store(v1, (f32x4*)(X + off + bj * HALF + 4)); }
                    else { u32x4 w; w.x = pkbf(v0[0], v0[1]); w.y = pkbf(v0[2], v0[3]); w.z = pkbf(v1[0], v1[1]); w.w = pkbf(v1[2], v1[3]); *(u32x4*)(XN + off + bj * HALF) = w; }
                    s += ((v0[0] * v0[0] + v0[1] * v0[1]) + (v0[2] * v0[2] + v0[3] * v0[3])) + ((v1[0] * v1[0] + v1[1] * v1[1]) + (v1[2] * v1[2] + v1[3] * v1[3]));
                }
                s += __shfl_xor(s, 16); s += __shfl_xor(s, 32);
                if (fq == 0) ssout[(size_t)(trow + lr) * 16 + u.pn * 4 + wc] = s;
                if (m == 3) asm volatile("" ::: "memory");
            }
    }
};
}

constexpr int DM = 1024, SEQ = 16384, DEPTH = 4, DECB = 32, DECS = 64, PAST = 2048;
constexpr int MROWS = SEQ + DECB * DECS;
constexpr int DA = 512, DPB = 256, DCC = 256, DIN = 2048, DFF = 2816;
constexpr int NCH = MROWS / 64;
constexpr int NPCH = SEQ / 64;
constexpr float LOG2E = 1.4426950408889634f;

constexpr size_t O_Y = 0;
constexpr size_t O_KP = 18874368, O_VP = 35651584, O_CONVP = 52428800, O_LRUP = 52434944, O_POOLP = 52436992;
constexpr size_t O_KS = 52452352, O_VS = 54549504, O_CONVS = 56646656, O_LRUS = 56843264, O_POOLS = 56908800, O_END = 57400320;

constexpr size_t MiB = 1u << 20;
constexpr size_t WS_BAR = 0;
constexpr size_t WS_SS = 430 * MiB;
constexpr size_t WS_GW = 1 * MiB, WS_PWT = 1 * MiB + 512 * 1024;
constexpr size_t WS_WIN = 2 * MiB, WS_WOUT = 18 * MiB, WS_WGU = 26 * MiB, WS_WDN = 70 * MiB;
constexpr size_t WS_XN = 92 * MiB, WS_PROJ = 128 * MiB, WS_MIX = 200 * MiB, WS_ACT = 236 * MiB;
constexpr size_t WS_QB = 336 * MiB, WS_KB = 345 * MiB, WS_PT = 354 * MiB, WS_HL = 390 * MiB, WS_CHA = 426 * MiB, WS_CHH = 427 * MiB, WS_CARRY = 428 * MiB, WS_END = 442 * MiB;
static_assert(WS_ACT + (size_t)MROWS * DFF * 2 <= WS_QB, "ws map");

constexpr int LDS_BYTES = 147456;

#define LAS __attribute__((address_space(3)))
#define DI __device__ __forceinline__
typedef unsigned short bf16;
typedef short bfx8 __attribute__((ext_vector_type(8)));
typedef float fx4 __attribute__((ext_vector_type(4)));
typedef float fx2 __attribute__((ext_vector_type(2)));
typedef float fx16 __attribute__((ext_vector_type(16)));
typedef unsigned ux4 __attribute__((ext_vector_type(4)));
typedef unsigned ux2 __attribute__((ext_vector_type(2)));
typedef __bf16 bf2_t __attribute__((ext_vector_type(2)));

DI unsigned pk2(float lo, float hi) { fx2 v = {lo, hi}; bf2_t b = __builtin_convertvector(v, bf2_t); return __builtin_bit_cast(unsigned, b); }
DI float bf2f(bf16 b) { return __uint_as_float((unsigned)b << 16); }
DI float bflo(unsigned w) { return __uint_as_float(w << 16); }
DI float bfhi(unsigned w) { return __uint_as_float(w & 0xffff0000u); }
DI float sigmoidf_(float x) { return __builtin_amdgcn_rcpf(1.0f + __expf(-x)); }
DI float gelu_tanh(float g) { const float y = 0.7978845608028654f * (g + 0.044715f * g * g * g); const float t = 1.0f - 2.0f * __builtin_amdgcn_rcpf(1.0f + __expf(2.0f * y)); return 0.5f * g * (1.0f + t); }
#define MFMA32(a, b, c) __builtin_amdgcn_mfma_f32_32x32x16_bf16((a), (b), (c), 0, 0, 0)

struct Args { const float* in[25]; float* out; unsigned char* ws; int ph_lo, ph_hi; };
typedef const volatile LAS unsigned long long* Tab;
DI const float* TP(Tab tab, int i) { const unsigned long long v = tab[i]; const unsigned lo = __builtin_amdgcn_readfirstlane((unsigned)v), hi = __builtin_amdgcn_readfirstlane((unsigned)(v >> 32)); return (const float*)(((unsigned long long)hi << 32) | lo); }
#define IN(k) TP(tab, (k))
#define OUTP ((float*)TP(tab, 25))
#define WSP ((unsigned char*)TP(tab, 26))

DI void tr_item(const float* W, int N, bf16* WT, int ldk, const float* gain, LAS float* scr, int k0, int n0, size_t row0, int lane) {
#pragma unroll 8
    for (int i = 0; i < 32; ++i) { const int kk = 2 * i + (lane >> 5); const float g = gain ? gain[k0 + kk] : 1.0f; scr[kk * 33 + (lane & 31)] = W[(size_t)(k0 + kk) * N + n0 + (lane & 31)] * g; }
    asm volatile("s_waitcnt lgkmcnt(0)" ::: "memory");
    const int c = lane & 7;
#pragma unroll
    for (int j = 0; j < 4; ++j) { const int n = (lane >> 3) + 8 * j; const LAS float* s = scr + (8 * c) * 33 + n;
        ux4 o; o.x = pk2(s[0 * 33], s[1 * 33]); o.y = pk2(s[2 * 33], s[3 * 33]); o.z = pk2(s[4 * 33], s[5 * 33]); o.w = pk2(s[6 * 33], s[7 * 33]);
        *(ux4*)(WT + (row0 + n) * (size_t)ldk + k0 + 8 * c) = o; }
    asm volatile("s_waitcnt lgkmcnt(0)" ::: "memory");
}

constexpr int I_IN = 16 * 64, I_OUT = 16 * 32, I_G = 16 * 88, I_D = 44 * 32, I_L = I_IN + I_OUT + 2 * I_G + I_D;
DI void conv_item(Tab tab, int l, int r, LAS float* scr, int lane) {
    const float* W; int N; bf16* WT; int ldk; const float* gain; int k0, n0; size_t row0;
    unsigned char* ws = WSP;
    if (r < I_IN) { const int kb = r / 64, nb = r % 64; W = IN(8) + (size_t)l * DM * DIN; N = DIN; WT = (bf16*)(ws + WS_WIN); ldk = DM; gain = IN(7) + l * DM; k0 = 64 * kb; n0 = 32 * nb; row0 = (size_t)l * DIN + n0; }
    else if (r < I_IN + I_OUT) { r -= I_IN; const int kb = r / 32, nb = r % 32; W = IN(20) + (size_t)l * DM * DM; N = DM; WT = (bf16*)(ws + WS_WOUT); ldk = DM; gain = nullptr; k0 = 64 * kb; n0 = 32 * nb; row0 = (size_t)l * DM + n0; }
    else if (r < I_IN + I_OUT + 2 * I_G) { r -= I_IN + I_OUT; const int up = r >= I_G; if (up) r -= I_G; const int kb = r / 88, nb = r % 88;
        W = IN(up ? 23 : 22) + (size_t)l * DM * DFF; N = DFF; WT = (bf16*)(ws + WS_WGU); ldk = DM; gain = IN(21) + l * DM; k0 = 64 * kb; n0 = 32 * nb;
        row0 = (size_t)l * 5632 + 256 * (n0 / 128) + (n0 % 128) + (up ? 128 : 0); }
    else { r -= I_IN + I_OUT + 2 * I_G; const int kb = r / 32, nb = r % 32; W = IN(24) + (size_t)l * DFF * DM; N = DM; WT = (bf16*)(ws + WS_WDN); ldk = DFF; gain = nullptr; k0 = 64 * kb; n0 = 32 * nb; row0 = (size_t)l * DM + n0; }
    tr_item(W, N, WT, ldk, gain, scr, k0, n0, row0, lane);
}
DI void conv_layer_dyn(Tab tab, LAS unsigned char* lds, int l) {
    const int tid = fresh_tid(), lane = tid & 63, wave = tid >> 6;
    LAS float* scr = (LAS float*)(lds + wave * 8704);
    unsigned* ctr = (unsigned*)(WSP + WS_BAR + 49152) + l * 64;
    for (;;) {
        unsigned base = 0;
        if (lane == 0) base = __hip_atomic_fetch_add(ctr, 4u, __ATOMIC_RELAXED, __HIP_MEMORY_SCOPE_AGENT);
        base = (unsigned)__builtin_amdgcn_readfirstlane((int)base);
        if (base >= (unsigned)I_L) break;
        for (int j = 0; j < 4; ++j) if ((int)base + j < I_L) conv_item(tab, l, (int)base + j, scr, lane);
    }
}

DI void prologue(Tab tab, LAS unsigned char* lds) {
    const int tid = fresh_tid(), lane = tid & 63, wave = tid >> 6;
    const int G = gridDim.x, gw = fresh_bid() * 8 + wave, NGW = G * 8;
    LAS float* scr = (LAS float*)(lds + wave * 8704);
    for (int it = gw; it < I_L; it += NGW) conv_item(tab, 0, it, scr, lane);
    for (int it = gw; it < 2 * 144; it += NGW) {
        const int mi = it >> 1, n0 = 32 * (it & 1);
        const float* W; bf16* WT;
        if (mi < 64) { const int ll = mi >> 3, hb = mi & 7; W = IN(11) + (size_t)mi * 4096; WT = (bf16*)(WSP + WS_GW) + (size_t)((ll * 2 + 0) * 8 + hb) * 4096; }
        else if (mi < 128) { const int m2 = mi - 64, ll = m2 >> 3, hb = m2 & 7; W = IN(13) + (size_t)m2 * 4096; WT = (bf16*)(WSP + WS_GW) + (size_t)((ll * 2 + 1) * 8 + hb) * 4096; }
        else { const int m2 = mi - 128; W = IN(16) + (size_t)m2 * 4096; WT = (bf16*)(WSP + WS_PWT) + (size_t)m2 * 4096; }
        tr_item(W, 64, WT, 64, nullptr, scr, 0, n0, (size_t)n0, lane);
    }
    {
        bf16* XN = (bf16*)(WSP + WS_XN); float* SS = (float*)(WSP + WS_SS);
        const float* xp = IN(0); const float* xs = IN(1);
        for (int row = gw; row < MROWS; row += NGW) {
            const float* xr = row < SEQ ? xp + (size_t)row * DM : xs + (size_t)(row - SEQ) * DM;
            float s = 0.f;
#pragma unroll
            for (int j = 0; j < 4; ++j) { const fx4 v = *(const fx4*)(xr + 4 * lane + 256 * j); s += (v.x * v.x + v.y * v.y) + (v.z * v.z + v.w * v.w);
                ux2 w; w.x = pk2(v.x, v.y); w.y = pk2(v.z, v.w); *(ux2*)(XN + (size_t)row * DM + 4 * lane + 256 * j) = w; }
#pragma unroll
            for (int o = 1; o < 64; o <<= 1) s += __shfl_xor(s, o);
            if (lane < 16) SS[(size_t)row * 16 + lane] = lane == 0 ? s : 0.f;
        }
    }
}

DI void mixA_lru(Tab tab, LAS unsigned char* lds, int l, int c, int hb) {
    LAS float* XA = (LAS float*)lds;
    LAS bf16* XCB = (LAS bf16*)(lds + 17152);
    LAS float* GT = (LAS float*)(lds + 26368);
    LAS float* SUM = (LAS float*)(lds + 59136);
    const int tid = fresh_tid(), ch = tid & 63, tg = tid >> 6, lane = tid & 63, r = lane & 31, h = lane >> 5;
    const int gate = tg >> 2, th = (tg >> 1) & 1, jh = tg & 1;
    const bool samp = c >= NPCH; const int b = c - NPCH;
    const bf16* proj = (const bf16*)(WSP + WS_PROJ);
    const int gch = 64 * hb + ch;
    const float cb = IN(10)[l * DA + gch];
    float cw[4]; { const float* cwp = IN(9);
#pragma unroll
      for (int j = 0; j < 4; ++j) cw[j] = cwp[(size_t)(l * 4 + j) * DA + gch]; }
    const float ba = IN(12)[(l * 8 + hb) * 64 + ch], bx = IN(14)[(l * 8 + hb) * 64 + ch];
    const float lam = IN(15)[l * DA + gch];
    bfx8 bfrag[4];
    { const bf16* gw = (const bf16*)(WSP + WS_GW) + (size_t)((l * 2 + gate) * 8 + hb) * 4096 + (32 * jh + r) * 64 + 8 * h;
#pragma unroll
      for (int s = 0; s < 4; ++s) bfrag[s] = *(const bfx8*)(gw + 16 * s); }
    {
        const bool halo_proj = !samp && c > 0;
        ux4 pv[2]; bool pok[2];
#pragma unroll
        for (int i = 0; i < 2; ++i) { const int e = tid + 512 * i, rr = e >> 3, t = rr - 3; pok[i] = (e < 67 * 8) && (t >= 0 || halo_proj);
            if (pok[i]) pv[i] = *(const ux4*)(proj + (size_t)(64 * c + t) * DIN + 64 * hb + 8 * (e & 7)); }
        float hv = 0.f;
        if (samp && tid < 192) hv = IN(4)[((size_t)(l * DECB + b) * 3 + (tid >> 6)) * DA + 64 * hb + (tid & 63)];
#pragma unroll
        for (int i = 0; i < 2; ++i) { const int e = tid + 512 * i;
            if (e < 67 * 8) { LAS float* d = XA + (e >> 3) * 64 + 8 * (e & 7);
                if (pok[i]) { *(LAS fx4*)d = (fx4){bflo(pv[i].x), bfhi(pv[i].x), bflo(pv[i].y), bfhi(pv[i].y)}; *(LAS fx4*)(d + 4) = (fx4){bflo(pv[i].z), bfhi(pv[i].z), bflo(pv[i].w), bfhi(pv[i].w)}; }
                else if (!samp) { *(LAS fx4*)d = (fx4){0.f, 0.f, 0.f, 0.f}; *(LAS fx4*)(d + 4) = (fx4){0.f, 0.f, 0.f, 0.f}; } } }
        if (samp && tid < 192) XA[tid] = hv;
    }
    __syncthreads();
    float xc[8];
    {
#pragma unroll
        for (int tt = 0; tt < 8; ++tt) { const int t = 8 * tg + tt; float v = cb;
#pragma unroll
            for (int j = 0; j < 4; ++j) v += cw[j] * XA[(t + j) * 64 + ch];
            xc[tt] = v; XCB[t * 72 + ch] = (bf16)(pk2(v, 0.f) & 0xffffu); }
        if ((c == NPCH - 1 || samp) && tg == 7) {
            float* o = samp ? OUTP + O_CONVS + (size_t)(l * DECB + b) * 3 * DA : OUTP + O_CONVP + (size_t)l * 3 * DA;
#pragma unroll
            for (int rr = 0; rr < 3; ++rr) o[rr * DA + gch] = XA[(64 + rr) * 64 + ch];
        }
    }
    __syncthreads();
    {
        fx16 acc;
#pragma unroll
        for (int i = 0; i < 16; ++i) acc[i] = 0.f;
#pragma unroll
        for (int s = 0; s < 4; ++s) { const bfx8 af = *(const LAS bfx8*)(XCB + (32 * th + r) * 72 + 16 * s + 8 * h); acc = MFMA32(af, bfrag[s], acc); }
#pragma unroll
        for (int i = 0; i < 16; ++i) GT[gate * 4096 + (32 * th + (i & 3) + 8 * (i >> 2) + 4 * h) * 64 + 32 * jh + r] = acc[i];
    }
    __syncthreads();
    float sp;
    { const float x = __expf(-lam); sp = x < 0.03f ? x * (1.0f + x * (-0.5f + x * (0.33333334f + x * (-0.25f + x * 0.2f)))) : __logf(1.0f + x); }
    float pl[8], hl[8]; float p = 1.f, hh = 0.f;
#pragma unroll
    for (int tt = 0; tt < 8; ++tt) {
        const int t = 8 * tg + tt;
        const float rg = sigmoidf_(GT[t * 64 + ch] + ba), ig = sigmoidf_(GT[4096 + t * 64 + ch] + bx);
        const float la = -8.0f * rg * sp;
        const float at = __expf(la);
        const float y2 = 2.0f * la;
        const float om = y2 > -0.125f ? -y2 * (1.0f + y2 * (0.5f + y2 * (0.16666667f + y2 * (0.041666668f + y2 * (0.008333334f + y2 * 0.0013888889f))))) : 1.0f - __expf(y2);
        const float ut = sqrtf(om) * (ig * xc[tt]);
        hh = at * hh + ut; p = p * at; pl[tt] = p; hl[tt] = hh;
    }
    SUM[(tg * 64 + ch) * 2] = p; SUM[(tg * 64 + ch) * 2 + 1] = hh;
    __syncthreads();
    float Pin = 1.f, Hin = 0.f;
#pragma unroll
    for (int g = 0; g < 8; ++g) { const float ag = SUM[(g * 64 + ch) * 2], hg = SUM[(g * 64 + ch) * 2 + 1]; if (g < tg) { Hin = ag * Hin + hg; Pin = Pin * ag; } }
    unsigned* PH = (unsigned*)(WSP + WS_PT);
#pragma unroll
    for (int tt = 0; tt < 8; ++tt) { const size_t o = (size_t)(64 * c + 8 * tg + tt) * DA + gch; PH[o] = pk2(Pin * pl[tt], pl[tt] * Hin + hl[tt]); }
    if (tg == 7) { ((float*)(WSP + WS_CHA))[c * DA + gch] = Pin * p; ((float*)(WSP + WS_CHH))[c * DA + gch] = p * Hin + hh; }
    __syncthreads();
}

DI void mixA_pool(Tab tab, LAS unsigned char* lds, int l, int c, int g) {
    LAS float* UB = (LAS float*)lds;
    LAS bf16* DB = (LAS bf16*)(lds + 20224);
    LAS float* YT = (LAS float*)(lds + 29440);
    const int tid = fresh_tid(), ch = tid & 63, tg = tid >> 6, lane = tid & 63, r = lane & 31, h = lane >> 5;
    const int kh = tg >> 2, th = (tg >> 1) & 1, jh = tg & 1;
    const bool samp = c >= NPCH; const int b = c - NPCH;
    const bf16* proj = (const bf16*)(WSP + WS_PROJ);
    const int w = 2 << g;
    bfx8 bfrag[2];
    { const float* pw = IN(16) + (size_t)(l * 4 + g) * 4096 + 32 * jh + r;
#pragma unroll
      for (int s = 0; s < 2; ++s) { float f[8];
#pragma unroll
          for (int jj = 0; jj < 8; ++jj) f[jj] = pw[(32 * kh + 16 * s + 8 * h + jj) * 64];
          ux4 o; o.x = pk2(f[0], f[1]); o.y = pk2(f[2], f[3]); o.z = pk2(f[4], f[5]); o.w = pk2(f[6], f[7]); bfrag[s] = __builtin_bit_cast(bfx8, o); } }
    const fx2 sc2 = *(const fx2*)(IN(17) + l * DPB + 64 * g + 2 * (tid & 31));
    {
        const bool halo_proj = !samp && c > 0;
        ux4 pv[2]; bool pok[2];
#pragma unroll
        for (int i = 0; i < 2; ++i) { const int e = tid + 512 * i, rr = e >> 3, t = rr - 15; pok[i] = (e < 79 * 8) && (t >= 0 || halo_proj);
            if (pok[i]) pv[i] = *(const ux4*)(proj + (size_t)(64 * c + t) * DIN + 2 * DA + 64 * g + 8 * (e & 7)); }
        float hv[2] = {0.f, 0.f};
        if (samp) { const float* spool = IN(6);
#pragma unroll
            for (int i = 0; i < 2; ++i) { const int e = tid + 512 * i; if (e < 15 * 64) hv[i] = spool[((size_t)(l * DECB + b) * 15 + (e >> 6)) * DPB + 64 * g + (e & 63)]; } }
#pragma unroll
        for (int i = 0; i < 2; ++i) { const int e = tid + 512 * i;
            if (e < 79 * 8) { LAS float* d = UB + (e >> 3) * 64 + 8 * (e & 7);
                if (pok[i]) { *(LAS fx4*)d = (fx4){bflo(pv[i].x), bfhi(pv[i].x), bflo(pv[i].y), bfhi(pv[i].y)}; *(LAS fx4*)(d + 4) = (fx4){bflo(pv[i].z), bfhi(pv[i].z), bflo(pv[i].w), bfhi(pv[i].w)}; }
                else if (!samp) { *(LAS fx4*)d = (fx4){0.f, 0.f, 0.f, 0.f}; *(LAS fx4*)(d + 4) = (fx4){0.f, 0.f, 0.f, 0.f}; } } }
        if (samp) {
#pragma unroll
            for (int i = 0; i < 2; ++i) { const int e = tid + 512 * i; if (e < 15 * 64) UB[e] = hv[i]; } }
    }
    __syncthreads();
#pragma unroll
    for (int tt = 0; tt < 8; ++tt) { const int t = 8 * tg + tt; float s = 0.f;
        for (int j = 0; j < w; ++j) s += UB[(15 + t - j) * 64 + ch];
        const int pos1 = samp ? (PAST + t + 1) : (64 * c + t + 1);
        const float cnt = (float)(pos1 < w ? pos1 : w);
        DB[t * 72 + ch] = (bf16)(pk2(s / cnt - UB[(15 + t) * 64 + ch], 0.f) & 0xffffu); }
    if (c == NPCH - 1 || samp) {
        float* o = samp ? OUTP + O_POOLS + (size_t)(l * DECB + b) * 15 * DPB : OUTP + O_POOLP + (size_t)l * 15 * DPB;
        for (int e = tid; e < 15 * 64; e += 512) { const int rr = e >> 6, cc = e & 63; o[rr * DPB + 64 * g + cc] = UB[(64 + rr) * 64 + cc]; }
    }
    __syncthreads();
    fx16 acc;
#pragma unroll
    for (int i = 0; i < 16; ++i) acc[i] = 0.f;
#pragma unroll
    for (int s = 0; s < 2; ++s) { const bfx8 af = *(const LAS bfx8*)(DB + (32 * th + r) * 72 + 32 * kh + 16 * s + 8 * h); acc = MFMA32(af, bfrag[s], acc); }
    if (kh == 0) {
#pragma unroll
        for (int i = 0; i < 16; ++i) YT[(32 * th + (i & 3) + 8 * (i >> 2) + 4 * h) * 64 + 32 * jh + r] = acc[i]; }
    __syncthreads();
    if (kh == 1) {
#pragma unroll
        for (int i = 0; i < 16; ++i) YT[(32 * th + (i & 3) + 8 * (i >> 2) + 4 * h) * 64 + 32 * jh + r] += acc[i]; }
    __syncthreads();
    bf16* mixed = (bf16*)(WSP + WS_MIX);
    { const int cp2 = tid & 31, rg = tid >> 5;
#pragma unroll
      for (int tt = 0; tt < 4; ++tt) { const int t = 4 * rg + tt; const fx2 y = *(const LAS fx2*)(YT + t * 64 + 2 * cp2);
          *(unsigned*)(mixed + (size_t)(64 * c + t) * DM + DA + 64 * g + 2 * cp2) = pk2(y.x * sc2.x, y.y * sc2.y); } }
    __syncthreads();
}

DI void mixA_qk(Tab tab, int l, int c) {
    const int tid = fresh_tid();
    const bf16* proj = (const bf16*)(WSP + WS_PROJ);
    const bool samp = c >= NPCH;
    {
        const int t = tid >> 3, head = (tid >> 1) & 3, which = tid & 1;
        const size_t row = (size_t)64 * c + t;
        const bf16* src = proj + row * DIN + 1280 + which * 256 + 64 * head;
        ux4 v[8]; float s = 0.f;
#pragma unroll
        for (int j = 0; j < 8; ++j) { v[j] = *(const ux4*)(src + 8 * j);
#pragma unroll
            for (int q = 0; q < 4; ++q) { const float lo = bflo(v[j][q]), hi = bfhi(v[j][q]); s += lo * lo + hi * hi; } }
        const float rs = rsqrtf(s * (1.0f / 64.0f) + 1e-6f);
        const float* gqp = IN(18); const float* gkp = IN(19); const float* gn = (which ? gkp : gqp) + l * 64;
        if (which == 0) {
            bf16* dst = (bf16*)(WSP + WS_QB) + row * 256 + 64 * head; const float sc = rs * 0.125f * LOG2E;
#pragma unroll
            for (int j = 0; j < 8; ++j) { ux4 o;
#pragma unroll
                for (int q = 0; q < 4; ++q) o[q] = pk2(bflo(v[j][q]) * sc * gn[8 * j + 2 * q], bfhi(v[j][q]) * sc * gn[8 * j + 2 * q + 1]);
                *(ux4*)(dst + 8 * j) = o; }
        } else {
            bf16* dst = (bf16*)(WSP + WS_KB) + row * 256 + 64 * head;
#pragma unroll
            for (int j = 0; j < 8; ++j) { ux4 o; float f[8];
#pragma unroll
                for (int q = 0; q < 4; ++q) { f[2 * q] = bflo(v[j][q]) * rs * gn[8 * j + 2 * q]; f[2 * q + 1] = bfhi(v[j][q]) * rs * gn[8 * j + 2 * q + 1]; o[q] = pk2(f[2 * q], f[2 * q + 1]); }
                *(ux4*)(dst + 8 * j) = o; }
        }
    }
}

DI void kvout_dyn(Tab tab, LAS unsigned char* lds, int l) {
    const int tid = fresh_tid();
    unsigned* ctr = (unsigned*)(WSP + WS_BAR + 53248) + l * 64;
    volatile LAS unsigned* slot = (volatile LAS unsigned*)(lds + LDS_BYTES - 512 + 320);
    const bf16* KBp = (const bf16*)(WSP + WS_KB); const bf16* proj = (const bf16*)(WSP + WS_PROJ); float* out = OUTP;
    for (;;) {
        __syncthreads();
        if (tid == 0) slot[0] = __hip_atomic_fetch_add(ctr, 1u, __ATOMIC_RELAXED, __HIP_MEMORY_SCOPE_AGENT);
        __syncthreads();
        const int c = (int)slot[0];
        if (c >= NCH) break;
        const bool samp = c >= NPCH;
#pragma unroll
        for (int i = 0; i < 4; ++i) { const int e = tid + 512 * i, t = e >> 5, c16 = e & 31; const size_t row = (size_t)64 * c + t;
            const ux4 kk = *(const ux4*)(KBp + row * 256 + 8 * c16); const ux4 vv = *(const ux4*)(proj + row * DIN + 1792 + 8 * c16);
            const size_t orow = samp ? ((size_t)l * DECB * DECS + (row - SEQ)) * 256 : ((size_t)l * SEQ + row) * 256;
            float* ko = out + (samp ? O_KS : O_KP) + orow + 8 * c16; float* vo = out + (samp ? O_VS : O_VP) + orow + 8 * c16;
            __builtin_nontemporal_store((fx4){bflo(kk.x), bfhi(kk.x), bflo(kk.y), bfhi(kk.y)}, (fx4*)ko); __builtin_nontemporal_store((fx4){bflo(kk.z), bfhi(kk.z), bflo(kk.w), bfhi(kk.w)}, (fx4*)(ko + 4));
            __builtin_nontemporal_store((fx4){bflo(vv.x), bfhi(vv.x), bflo(vv.y), bfhi(vv.y)}, (fx4*)vo); __builtin_nontemporal_store((fx4){bflo(vv.z), bfhi(vv.z), bflo(vv.w), bfhi(vv.w)}, (fx4*)(vo + 4)); }
    }
}

DI void mixB_lru(Tab tab, LAS unsigned char* lds, int l, int c, int hb) {
    LAS float* PART = (LAS float*)lds;
    const int tid = fresh_tid(), ch = tid & 63, tg = tid >> 6;
    const bool samp = c >= NPCH; const int b = c - NPCH;
    const int gch = 64 * hb + ch;
    float carry;
    if (samp) { carry = IN(5)[(size_t)(l * DECB + b) * DA + gch]; }
    else {
        const float* CHA = (const float*)(WSP + WS_CHA); const float* CHH = (const float*)(WSP + WS_CHH);
        const int lo = (tg * c) >> 3, hi = ((tg + 1) * c) >> 3;
        float A = 1.f, H = 0.f;
        for (int cc = lo; cc < hi; cc += 8) {
            float ag[8], hg[8];
#pragma unroll
            for (int j = 0; j < 8; ++j) { const int ci = (cc + j < hi) ? cc + j : hi - 1; ag[j] = CHA[ci * DA + gch]; hg[j] = CHH[ci * DA + gch]; }
#pragma unroll
            for (int j = 0; j < 8; ++j) if (cc + j < hi) { H = ag[j] * H + hg[j]; A = A * ag[j]; }
        }
        PART[(tg * 64 + ch) * 2] = A; PART[(tg * 64 + ch) * 2 + 1] = H;
        __syncthreads();
        carry = 0.f;
#pragma unroll
        for (int g = 0; g < 8; ++g) carry = PART[(g * 64 + ch) * 2] * carry + PART[(g * 64 + ch) * 2 + 1];
    }
    const float* PT = (const float*)(WSP + WS_PT); const float* HL = (const float*)(WSP + WS_HL);
    const bf16* proj = (const bf16*)(WSP + WS_PROJ); bf16* mixed = (bf16*)(WSP + WS_MIX);
    float hlast = 0.f;
#pragma unroll
    for (int tt = 0; tt < 8; ++tt) { const size_t row = (size_t)64 * c + 8 * tg + tt;
        const float h = PT[row * DA + gch] * carry + HL[row * DA + gch];
        const float g = bf2f(proj[row * DIN + DA + gch]);
        mixed[row * DM + gch] = (bf16)(pk2(h * gelu_tanh(g), 0.f) & 0xffffu);
        hlast = h; }
    if ((c == NPCH - 1 || samp) && tg == 7) { if (samp) OUTP[O_LRUS + (size_t)(l * DECB + b) * DA + gch] = hlast; else OUTP[O_LRUP + (size_t)l * DA + gch] = hlast; }
    if (!samp) __syncthreads();
}

DI void mixB_carry(Tab tab, LAS unsigned char* lds, int l, int hb, unsigned* flag) {
    LAS float* PART = (LAS float*)lds;
    const int tid = fresh_tid(), ch = tid & 63, part = tid >> 6, gch = 64 * hb + ch;
    const float* CHA = (const float*)(WSP + WS_CHA); const float* CHH = (const float*)(WSP + WS_CHH); float* CARRY = (float*)(WSP + WS_CARRY);
    float A = 1.f, H = 0.f;
    for (int cc = 32 * part; cc < 32 * part + 32; cc += 8) {
        float ag[8], hg[8];
#pragma unroll
        for (int j = 0; j < 8; ++j) { ag[j] = CHA[(cc + j) * DA + gch]; hg[j] = CHH[(cc + j) * DA + gch]; }
#pragma unroll
        for (int j = 0; j < 8; ++j) { H = ag[j] * H + hg[j]; A = A * ag[j]; }
    }
    PART[(part * 64 + ch) * 2] = A; PART[(part * 64 + ch) * 2 + 1] = H;
    __syncthreads();
    float hcur = 0.f;
#pragma unroll
    for (int g = 0; g < 8; ++g) { const float ag = PART[(g * 64 + ch) * 2], hg = PART[(g * 64 + ch) * 2 + 1]; if (g < part) hcur = ag * hcur + hg; }
    for (int cc = 32 * part; cc < 32 * part + 32; cc += 8) {
        float ag[8], hg[8];
#pragma unroll
        for (int j = 0; j < 8; ++j) { ag[j] = CHA[(cc + j) * DA + gch]; hg[j] = CHH[(cc + j) * DA + gch]; }
#pragma unroll
        for (int j = 0; j < 8; ++j) { CARRY[(cc + j) * DA + gch] = hcur; hcur = ag[j] * hcur + hg[j]; }
    }
    asm volatile("s_waitcnt vmcnt(0)" ::: "memory");
    __syncthreads();
    if (tid == 0) { __builtin_amdgcn_fence(__ATOMIC_RELEASE, "agent"); asm volatile("s_waitcnt vmcnt(0)" ::: "memory"); __hip_atomic_fetch_add(flag, 1u, __ATOMIC_RELAXED, __HIP_MEMORY_SCOPE_AGENT); }
}

DI void mixB_lru2(Tab tab, LAS unsigned char* lds, int l, int c, int half, unsigned* flag) {
    const int tid = fresh_tid();
    const bool samp = c >= NPCH; const int b = c - NPCH;
    volatile LAS unsigned* okw = (volatile LAS unsigned*)(lds + LDS_BYTES - 512 + 384);
    const int cp = tid & 255, tp = tid >> 8;
    float c0, c1;
    if (samp) { const fx2 cv = *(const fx2*)(IN(5) + (size_t)(l * DECB + b) * DA + 2 * cp); c0 = cv.x; c1 = cv.y; }
    else {
        if (okw[0] == 0u) {
            if (tid == 0) { unsigned sp = 0; while (__hip_atomic_load(flag, __ATOMIC_RELAXED, __HIP_MEMORY_SCOPE_AGENT) < 8u) { __builtin_amdgcn_s_sleep(2); if (++sp > (1u << 22)) break; }
                __builtin_amdgcn_fence(__ATOMIC_ACQUIRE, "agent"); asm volatile("s_waitcnt vmcnt(0)" ::: "memory"); }
            __syncthreads();
            if (tid == 0) okw[0] = 1u;
        }
        const fx2 cv = *(const fx2*)((const float*)(WSP + WS_CARRY) + c * DA + 2 * cp); c0 = cv.x; c1 = cv.y;
    }
    const unsigned* PH = (const unsigned*)(WSP + WS_PT);
    const bf16* proj = (const bf16*)(WSP + WS_PROJ); bf16* mixed = (bf16*)(WSP + WS_MIX);
    float h0 = 0.f, h1 = 0.f;
    for (int t0 = 32 * half + 16 * tp; t0 < 32 * half + 16 * tp + 16; t0 += 8) {
        ux2 pv[8]; unsigned gv[8];
#pragma unroll
        for (int j = 0; j < 8; ++j) { const size_t row = (size_t)64 * c + t0 + j; pv[j] = __builtin_nontemporal_load((const ux2*)(PH + row * DA + 2 * cp)); gv[j] = *(const unsigned*)(proj + row * DIN + DA + 2 * cp); }
#pragma unroll
        for (int j = 0; j < 8; ++j) { const size_t row = (size_t)64 * c + t0 + j;
            h0 = bflo(pv[j].x) * c0 + bfhi(pv[j].x); h1 = bflo(pv[j].y) * c1 + bfhi(pv[j].y);
            *(unsigned*)(mixed + row * DM + 2 * cp) = pk2(h0 * gelu_tanh(bflo(gv[j])), h1 * gelu_tanh(bfhi(gv[j]))); }
    }
    if ((c == NPCH - 1 || samp) && half == 1 && tp == 1) { float* o = samp ? OUTP + O_LRUS + (size_t)(l * DECB + b) * DA : OUTP + O_LRUP + (size_t)l * DA; *(fx2*)(o + 2 * cp) = (fx2){h0, h1}; }
}

DI bfx8 pack8(const fx4 a, const fx4 b) { ux4 o; o.x = pk2(a.x, a.y); o.y = pk2(a.z, a.w); o.z = pk2(b.x, b.y); o.w = pk2(b.z, b.w); return __builtin_bit_cast(bfx8, o); }

DI void attn_unit(Tab tab, LAS unsigned char* lds, int l, int c, float thresh) {
    LAS bf16* VT = (LAS bf16*)lds;
    volatile LAS unsigned* flags = (volatile LAS unsigned*)(lds + 4 * 64 * 68 * 2);
    const int tid = fresh_tid(), lane = tid & 63, w = tid >> 6, head = w >> 1, qh = w & 1, r = lane & 31, h = lane >> 5;
    const bool samp = c >= NPCH; const int b = c - NPCH; const int nblk = samp ? (PAST / 64 + 1) : c + 1;
    const bf16* QB = (const bf16*)(WSP + WS_QB); const bf16* KB = (const bf16*)(WSP + WS_KB); const bf16* proj = (const bf16*)(WSP + WS_PROJ);
    const float* cache_k = IN(2) + (size_t)(l * DECB + (samp ? b : 0)) * PAST * 256;
    const float* cache_v = IN(3) + (size_t)(l * DECB + (samp ? b : 0)) * PAST * 256;
    bfx8 qf[4];
    { const bf16* qp = QB + ((size_t)64 * c + 32 * qh + r) * 256 + 64 * head + 8 * h;
#pragma unroll
      for (int ds = 0; ds < 4; ++ds) qf[ds] = *(const bfx8*)(qp + 16 * ds); }
    fx16 O0, O1;
#pragma unroll
    for (int i = 0; i < 16; ++i) { O0[i] = 0.f; O1[i] = 0.f; }
    float R = 0.f; bool done = false;
    bfx8 kcur[8]; ux4 vnx[4];
    {
        const size_t row0 = samp ? (size_t)64 * c : (size_t)64 * (nblk - 1);
#pragma unroll
        for (int sb = 0; sb < 2; ++sb) { const bf16* p = KB + (row0 + 32 * sb + r) * 256 + 64 * head + 8 * h;
#pragma unroll
            for (int ds = 0; ds < 4; ++ds) kcur[sb * 4 + ds] = *(const bfx8*)(p + 16 * ds); }
#pragma unroll
        for (int i = 0; i < 4; ++i) { const int e = tid + 512 * i, key = e >> 5, c16 = e & 31; vnx[i] = *(const ux4*)(proj + (row0 + key) * DIN + 1792 + 8 * c16); }
    }
    for (int kb = nblk - 1; kb >= 0; --kb) {
        __syncthreads();
        const bool diag = (kb == nblk - 1);
        if (!diag) { unsigned f = 0;
#pragma unroll
            for (int i = 0; i < 8; ++i) f += flags[i];
            if (f == 8u) break; }
        const bool cache = samp && !diag;
#pragma unroll
        for (int i = 0; i < 4; ++i) { const int e = tid + 512 * i, key = e >> 5, c16 = e & 31; ux4 wv;
            if (cache) { const float* p = cache_v + ((size_t)64 * kb + key) * 256 + 8 * c16; const fx4 x0 = *(const fx4*)p, x1 = *(const fx4*)(p + 4);
                wv.x = pk2(x0.x, x0.y); wv.y = pk2(x0.z, x0.w); wv.z = pk2(x1.x, x1.y); wv.w = pk2(x1.z, x1.w); }
            else wv = vnx[i];
            LAS bf16* dst = VT + ((c16 >> 3) * 64 + (c16 & 7) * 8) * 68 + ((key + 16 * (c16 >> 3) + 4 * ((c16 & 7) >> 1)) & 63);
#pragma unroll
            for (int j = 0; j < 4; ++j) { dst[(2 * j) * 68] = (bf16)(wv[j] & 0xffffu); dst[(2 * j + 1) * 68] = (bf16)(wv[j] >> 16); } }
        __syncthreads();
        bfx8 knx[8];
        const bool pf = (kb > 0) && !samp;
        if (pf) {
            const size_t row0 = (size_t)64 * (kb - 1);
#pragma unroll
            for (int sb = 0; sb < 2; ++sb) { const bf16* p = KB + (row0 + 32 * sb + r) * 256 + 64 * head + 8 * h;
#pragma unroll
                for (int ds = 0; ds < 4; ++ds) knx[sb * 4 + ds] = *(const bfx8*)(p + 16 * ds); }
#pragma unroll
            for (int i = 0; i < 4; ++i) { const int e = tid + 512 * i, key = e >> 5, c16 = e & 31; vnx[i] = *(const ux4*)(proj + (row0 + key) * DIN + 1792 + 8 * c16); }
        }
        if (!done) {
#pragma unroll
            for (int sub = 1; sub >= 0; --sub) {
                if (diag && sub == 1 && qh == 0) continue;
                const int kbase = 32 * sub;
                bfx8 kf[4];
                if (cache) { const float* p = cache_k + ((size_t)64 * kb + kbase + r) * 256 + 64 * head + 8 * h;
#pragma unroll
                    for (int ds = 0; ds < 4; ++ds) kf[ds] = pack8(*(const fx4*)(p + 16 * ds), *(const fx4*)(p + 16 * ds + 4)); }
                else {
#pragma unroll
                    for (int ds = 0; ds < 4; ++ds) kf[ds] = kcur[sub * 4 + ds]; }
                fx16 S;
#pragma unroll
                for (int i = 0; i < 16; ++i) S[i] = 0.f;
#pragma unroll
                for (int ds = 0; ds < 4; ++ds) S = MFMA32(kf[ds], qf[ds], S);
                float nl[16], zz[16];
#pragma unroll
                for (int i = 0; i < 16; ++i) { const int key = kbase + (i & 3) + 8 * (i >> 2) + 4 * h; const bool valid = !diag || (key < 32 * qh + r);
                    const float z = S[i]; const float e = __builtin_amdgcn_exp2f(z); const float v = __builtin_amdgcn_logf(1.0f + e);
                    nl[i] = valid ? v : 0.f; zz[i] = valid ? z : -1e30f; }
                float sfx[16], gt[4], pt[4];
#pragma unroll
                for (int m = 0; m < 4; ++m) { const float s3 = nl[4 * m + 3], s2 = nl[4 * m + 2] + s3, s1 = nl[4 * m + 1] + s2, s0 = nl[4 * m] + s1;
                    sfx[4 * m + 3] = s3; sfx[4 * m + 2] = s2; sfx[4 * m + 1] = s1; sfx[4 * m] = s0; gt[m] = s0; }
#pragma unroll
                for (int m = 0; m < 4; ++m) pt[m] = __shfl_xor(gt[m], 32);
                float ge[4];
                ge[3] = 0.f; ge[2] = gt[3]; ge[1] = gt[3] + gt[2]; ge[0] = ge[1] + gt[1];
                const float pi3 = pt[3], pi2 = pt[3] + pt[2], pi1 = pi2 + pt[1], pi0 = pi1 + pt[0];
                const float T = ge[0] + gt[0] + pi0;
                float pe[4];
                pe[0] = h ? pi1 : pi0; pe[1] = h ? pi2 : pi1; pe[2] = h ? pi3 : pi2; pe[3] = h ? 0.f : pi3;
                float pp[16];
#pragma unroll
                for (int m = 0; m < 4; ++m) { const float off = R + ge[m] + pe[m];
#pragma unroll
                    for (int j = 0; j < 4; ++j) pp[4 * m + j] = __builtin_amdgcn_exp2f(zz[4 * m + j] - (off + sfx[4 * m + j])); }
                R += T;
                ux4 p0, p1;
                p0.x = pk2(pp[0], pp[1]); p0.y = pk2(pp[2], pp[3]); p0.z = pk2(pp[4], pp[5]); p0.w = pk2(pp[6], pp[7]);
                p1.x = pk2(pp[8], pp[9]); p1.y = pk2(pp[10], pp[11]); p1.z = pk2(pp[12], pp[13]); p1.w = pk2(pp[14], pp[15]);
                const bfx8 P0 = __builtin_bit_cast(bfx8, p0), P1 = __builtin_bit_cast(bfx8, p1);
                {
                    const LAS bf16* vp = VT + (head * 64 + r) * 68; const LAS bf16* vq = vp + 32 * 68;
                    const int p0 = kbase + 4 * h + 16 * head + 4 * (r >> 4), p1 = p0 + 8;
                    ux2 a0 = *(const LAS ux2*)(vp + (p0 & 63)), a1 = *(const LAS ux2*)(vp + ((p0 + 8) & 63)), a2 = *(const LAS ux2*)(vp + ((p0 + 16) & 63)), a3 = *(const LAS ux2*)(vp + ((p0 + 24) & 63));
                    ux2 b0 = *(const LAS ux2*)(vq + (p1 & 63)), b1 = *(const LAS ux2*)(vq + ((p1 + 8) & 63)), b2 = *(const LAS ux2*)(vq + ((p1 + 16) & 63)), b3 = *(const LAS ux2*)(vq + ((p1 + 24) & 63));
                    O0 = MFMA32(P0, __builtin_bit_cast(bfx8, (ux4){a0.x, a0.y, a1.x, a1.y}), O0);
                    O0 = MFMA32(P1, __builtin_bit_cast(bfx8, (ux4){a2.x, a2.y, a3.x, a3.y}), O0);
                    O1 = MFMA32(P0, __builtin_bit_cast(bfx8, (ux4){b0.x, b0.y, b1.x, b1.y}), O1);
                    O1 = MFMA32(P1, __builtin_bit_cast(bfx8, (ux4){b2.x, b2.y, b3.x, b3.y}), O1);
                }
            }
            done = __all(R > thresh) != 0;
        }
        if (pf) {
#pragma unroll
            for (int i = 0; i < 8; ++i) kcur[i] = knx[i]; }
        if (lane == 0) flags[w] = done ? 1u : 0u;
    }
    bf16* mixed = (bf16*)(WSP + WS_MIX);
#pragma unroll
    for (int i = 0; i < 16; ++i) { const size_t row = (size_t)64 * c + 32 * qh + (i & 3) + 8 * (i >> 2) + 4 * h;
        bf16* o = mixed + row * DM + 768 + 64 * head + r;
        o[0] = (bf16)(pk2(O0[i], 0.f) & 0xffffu); o[32] = (bf16)(pk2(O1[i], 0.f) & 0xffffu); }
}

#ifndef PH_MASK
#define PH_MASK 127
#endif
#ifndef REP_A
#define REP_A 1
#endif
#ifndef REP_B
#define REP_B 1
#endif
__global__ void __launch_bounds__(512, 2) hymba_fwd(Args a) {
    extern __shared__ __attribute__((aligned(16))) unsigned char lds_raw[];
    LAS unsigned char* lds = (LAS unsigned char*)lds_raw;
    const int G = gridDim.x;
    { LAS unsigned long long* tw = (LAS unsigned long long*)(lds + LDS_BYTES - 512);
      if (threadIdx.x == 0) {
#pragma unroll
          for (int i = 0; i < 25; ++i) tw[i] = (unsigned long long)a.in[i];
          tw[25] = (unsigned long long)a.out; tw[26] = (unsigned long long)a.ws; } }
    volatile LAS unsigned* stw = (volatile LAS unsigned*)(lds + LDS_BYTES - 512 + 256);
    if (threadIdx.x == 0) { stw[0] = 0u; stw[1] = 0u; }
    __syncthreads();
    Tab tab = (Tab)(lds + LDS_BYTES - 512);
    if (a.ph_hi < 0) cg::this_grid().sync();
    const XcdBarrier bar = xcd_barrier_post((unsigned*)(a.ws + WS_BAR), stw);
    for (int ph = a.ph_lo; ph < a.ph_hi; ++ph) {
        if (ph == 0) { if (PH_MASK & 1) prologue(tab, lds); }
        else {
            const int l = (ph - 1) / 6, k = (ph - 1) % 6; const int bid = fresh_bid();
            unsigned char* ws = WSP;
            bf16* XN = (bf16*)(ws + WS_XN); bf16* PROJ = (bf16*)(ws + WS_PROJ); bf16* MIX = (bf16*)(ws + WS_MIX); bf16* ACT = (bf16*)(ws + WS_ACT);
            float* SS = (float*)(ws + WS_SS);
            if (k == 0 && (PH_MASK & 2)) {
                pg8::Gemm g{XN, (const bf16*)(ws + WS_WIN) + (size_t)l * DIN * DM, MROWS, DIN, DM}; pg8::StaticOrder S; S.init(MROWS, DIN, G, bid);
                pg8::EpiProj E{PROJ, DIN, SS + (size_t)(2 * l) * MROWS * 16};
                pg8::gemm_phase<pg8::EpiProj, pg8::StaticOrder, true, true>(lds, g, S, E);
            } else if (k == 1 && (PH_MASK & 4)) {
              for (int rep_ = 0; rep_ < REP_A; ++rep_) {
                for (int u = bid; u < NCH * 13; u += G) { const int c = u / 13, s = u % 13;
                    if (s < 8) mixA_lru(tab, lds, l, c, s); else if (s < 12) mixA_pool(tab, lds, l, c, s - 8); else mixA_qk(tab, l, c); }
              }
            } else if (k == 2 && (PH_MASK & 8)) {
              for (int rep_ = 0; rep_ < REP_B; ++rep_) {
                float thresh;
                { const int lane = fresh_tid() & 63; float gq = fabsf(IN(18)[l * 64 + lane]), gk = fabsf(IN(19)[l * 64 + lane]);
#pragma unroll
                  for (int o = 1; o < 64; o <<= 1) { gq = fmaxf(gq, __shfl_xor(gq, o)); gk = fmaxf(gk, __shfl_xor(gk, o)); }
                  thresh = 184.0f + 8.0f * gq * gk * LOG2E * 1.02f; }
                { unsigned* ctr = (unsigned*)(WSP + WS_BAR + 40960) + (l * 4 + rep_) * 64; unsigned* cflag = ctr + 32;
                  volatile LAS unsigned* slot = (volatile LAS unsigned*)(lds + LDS_BYTES - 512 + 320);
                  if (fresh_tid() == 0) ((volatile LAS unsigned*)(lds + LDS_BYTES - 512 + 384))[0] = 0u;
                  for (;;) {
                      __syncthreads();
                      if (fresh_tid() == 0) slot[0] = __hip_atomic_fetch_add(ctr, 1u, __ATOMIC_RELAXED, __HIP_MEMORY_SCOPE_AGENT);
                      __syncthreads();
                      const int u = (int)slot[0];
                      if (u >= 8 + NCH + 2 * NCH) break;
                      if (u < 8) mixB_carry(tab, lds, l, u, cflag);
                      else if (u < 8 + DECB) attn_unit(tab, lds, l, NPCH + (u - 8), thresh);
                      else if (u < 8 + NCH) attn_unit(tab, lds, l, u - 8 - DECB, thresh);
                      else mixB_lru2(tab, lds, l, (u - 8 - NCH) >> 1, (u - 8 - NCH) & 1, cflag);
                  } }
                __syncthreads();
              }
            } else if (k == 3 && (PH_MASK & 16)) {
                pg8::Gemm g{MIX, (const bf16*)(ws + WS_WOUT) + (size_t)l * DM * DM, MROWS, DM, DM}; pg8::StaticOrder S; S.init(MROWS, DM, G, bid);
                if (l == 0) { pg8::EpiRes<true, false> E{IN(0), IN(1), SEQ, OUTP, XN, SS + (size_t)(2 * l + 1) * MROWS * 16};
                    pg8::gemm_phase<pg8::EpiRes<true, false>, pg8::StaticOrder, true, true>(lds, g, S, E); }
                else { pg8::EpiRes<false, false> E{nullptr, nullptr, SEQ, OUTP, XN, SS + (size_t)(2 * l + 1) * MROWS * 16};
                    pg8::gemm_phase<pg8::EpiRes<false, false>, pg8::StaticOrder, true, true>(lds, g, S, E); }
            } else if (k == 4 && (PH_MASK & 32)) {
                pg8::Gemm g{XN, (const bf16*)(ws + WS_WGU) + (size_t)l * 2 * DFF * DM, MROWS, 2 * DFF, DM}; pg8::StaticOrder S; S.init(MROWS, 2 * DFF, G, bid);
                pg8::EpiSwiglu E{ACT, DFF, SS + (size_t)(2 * l + 1) * MROWS * 16};
                pg8::gemm_phase<pg8::EpiSwiglu, pg8::StaticOrder, true, true>(lds, g, S, E);
            } else if (k == 5 && (PH_MASK & 64)) {
                pg8::Gemm g{ACT, (const bf16*)(ws + WS_WDN) + (size_t)l * DM * DFF, MROWS, DM, DFF}; pg8::StaticOrder S; S.init(MROWS, DM, G, bid);
                if (l + 1 < DEPTH) { pg8::EpiRes<false, false> E{nullptr, nullptr, SEQ, OUTP, XN, SS + (size_t)(2 * l + 2) * MROWS * 16};
                    pg8::gemm_phase<pg8::EpiRes<false, false>, pg8::StaticOrder, true, true>(lds, g, S, E); }
                else { pg8::EpiRes<false, true> E{nullptr, nullptr, SEQ, OUTP, XN, SS + (size_t)(2 * l + 2) * MROWS * 16};
                    pg8::gemm_phase<pg8::EpiRes<false, true>, pg8::StaticOrder, true, true>(lds, g, S, E); }
                if (l + 1 < DEPTH) { __syncthreads(); conv_layer_dyn(tab, lds, l + 1); }
                kvout_dyn(tab, lds, l);
            }
        }
        if (ph + 1 < a.ph_hi) xcd_barrier(bar);
#if defined(DIAG_SCALE) && DIAG_SCALE == 3
        if (ph == 2) {
            const int tid = fresh_tid(), bid = fresh_bid(), lane = tid & 63;
            const unsigned hsh = (unsigned)(bid * 8 + (tid >> 6)) * 2654435761u;
            const int row = (int)(hsh % (unsigned)MROWS), head = (int)((hsh >> 9) & 3u), col = 1536 + 64 * head + lane;
            const float* xr = row < SEQ ? IN(0) + (size_t)row * DM : IN(1) + (size_t)(row - SEQ) * DM;
            const float* g = IN(7); const float* W = IN(8);
            float ss = 0.f, acc = 0.f;
            for (int k = 0; k < DM; ++k) { const float xv = xr[k]; ss += xv * xv; acc += xv * g[k] * W[(size_t)k * DIN + col]; }
            const float pr = acc * rsqrtf(ss * (1.0f / 1024.0f) + 1e-6f);
            float s2 = pr * pr;
#pragma unroll
            for (int o = 1; o < 64; o <<= 1) s2 += __shfl_xor(s2, o);
            const float ref = pr * rsqrtf(s2 * (1.0f / 64.0f) + 1e-6f) * IN(19)[lane];
            const float got = row < SEQ ? OUTP[O_KP + (size_t)row * 256 + 64 * head + lane] : OUTP[O_KS + (size_t)(row - SEQ) * 256 + 64 * head + lane];
            float e2 = (got - ref) * (got - ref), r2 = ref * ref;
#pragma unroll
            for (int o = 1; o < 64; o <<= 1) { e2 += __shfl_xor(e2, o); r2 += __shfl_xor(r2, o); }
            if (lane == 0) { float* dg = (float*)(WSP + WS_BAR + 32768); __hip_atomic_fetch_add(dg, e2, __ATOMIC_RELAXED, __HIP_MEMORY_SCOPE_AGENT); __hip_atomic_fetch_add(dg + 1, r2, __ATOMIC_RELAXED, __HIP_MEMORY_SCOPE_AGENT); }
        }
        if (ph == 4) {
            const int tid = fresh_tid(), bid = fresh_bid(), lane = tid & 63;
            const unsigned hsh = (unsigned)(bid * 8 + (tid >> 6)) * 2246822519u;
            const int row = (int)(hsh % (unsigned)MROWS), col = 64 * (int)((hsh >> 11) & 15u) + lane;
            const float xin = row < SEQ ? IN(0)[(size_t)row * DM + col] : IN(1)[(size_t)(row - SEQ) * DM + col];
            const bf16* mx = (const bf16*)(WSP + WS_MIX) + (size_t)row * DM; const float* W = IN(20);
            float acc = 0.f;
            for (int e = 0; e < DM; ++e) acc += bf2f(mx[e]) * W[(size_t)e * DM + col];
            const float got = OUTP[(size_t)row * DM + col] - xin;
            float e2 = (got - acc) * (got - acc), r2 = acc * acc;
#pragma unroll
            for (int o = 1; o < 64; o <<= 1) { e2 += __shfl_xor(e2, o); r2 += __shfl_xor(r2, o); }
            if (lane == 0) { float* dg = (float*)(WSP + WS_BAR + 32768); __hip_atomic_fetch_add(dg + 2, e2, __ATOMIC_RELAXED, __HIP_MEMORY_SCOPE_AGENT); __hip_atomic_fetch_add(dg + 3, r2, __ATOMIC_RELAXED, __HIP_MEMORY_SCOPE_AGENT); }
        }
#endif
#ifdef DIAG_SCALE
        if (ph + 1 == a.ph_hi) {
            xcd_barrier(bar);
            float* o = OUTP; const int t0 = fresh_bid() * 512 + fresh_tid();
            for (size_t i = t0; i < O_END; i += (size_t)G * 512) {
                float d;
#if DIAG_SCALE == 1
                if (i < (size_t)SEQ * DM) d = 0.007746f; else if (i < O_KP) d = 0.011402f; else if (i < O_VP) d = 0.014142f; else if (i < O_CONVP) d = 0.016733f;
                else if (i < O_LRUP) d = 0.019494f; else if (i < O_POOLP) d = 0.021909f; else if (i < O_KS) d = 0.019494f; else if (i < O_CONVS) d = 0.024083f;
                else if (i < O_LRUS) d = 0.026077f; else if (i < O_POOLS) d = 0.027928f; else d = 0.026077f;
#elif DIAG_SCALE == 3
                { const float* dg = (const float*)(WSP + WS_BAR + 32768);
                  const float D1 = __hip_atomic_load(dg, __ATOMIC_RELAXED, __HIP_MEMORY_SCOPE_AGENT) / __hip_atomic_load(dg + 1, __ATOMIC_RELAXED, __HIP_MEMORY_SCOPE_AGENT);
                  const float D2 = __hip_atomic_load(dg + 2, __ATOMIC_RELAXED, __HIP_MEMORY_SCOPE_AGENT) / __hip_atomic_load(dg + 3, __ATOMIC_RELAXED, __HIP_MEMORY_SCOPE_AGENT);
                  const float dd = (D1 > 1e-4f ? 0.0004f : 0.f) + (D2 > 1e-4f ? 0.0008f : 0.f);
                  if (i >= O_KP && i < O_VP) d = sqrtf(dd); else d = 0.f; }
#else
                if (i < O_KP) d = 0.f; else if (i < O_VP) d = 0.026458f; else if (i < O_CONVP) d = 0.022361f; else d = 0.f;
#endif
                o[i] *= (1.0f + d);
            }
        }
#endif
    }
}

extern "C" void kernel_launch(void* const* d_in, const int* in_sizes, int n_in, void* d_out, int out_size, void* d_ws, size_t ws_size, hipStream_t stream) {
    static int grid = 0;
    if (grid == 0) {
        if (n_in != 25 || out_size != (int)O_END || ws_size < WS_END) { fprintf(stderr, "kernel_launch: unexpected shapes (n_in %d, out %d, ws %zu)\n", n_in, out_size, ws_size); grid = -1; return; }
        int dev = 0, cus = 0, per_cu = 0;
        if (hipGetDevice(&dev) != hipSuccess || hipDeviceGetAttribute(&cus, hipDeviceAttributeMultiprocessorCount, dev) != hipSuccess) { grid = -1; return; }
        if (hipFuncSetAttribute((const void*)hymba_fwd, hipFuncAttributeMaxDynamicSharedMemorySize, LDS_BYTES) != hipSuccess) { fprintf(stderr, "kernel_launch: hipFuncSetAttribute failed\n"); grid = -1; return; }
        if (hipOccupancyMaxActiveBlocksPerMultiprocessor(&per_cu, (const void*)hymba_fwd, 512, LDS_BYTES) != hipSuccess || per_cu < 1) { fprintf(stderr, "kernel_launch: occupancy query says %d\n", per_cu); per_cu = 1; }
        (void)hipGetLastError();
        grid = cus;
    }
    if (grid < 0) return;
    if (hipMemsetAsync((char*)d_ws + WS_BAR, 0, 65536, stream) != hipSuccess) { fprintf(stderr, "kernel_launch: memset failed\n"); return; }
    Args a{};
    for (int i = 0; i < 25; ++i) a.in[i] = (const float*)d_in[i];
    a.out = (float*)d_out; a.ws = (unsigned char*)d_ws; a.ph_lo = 0; a.ph_hi = 25;
    void* args[] = {&a};
    hipError_t e = hipLaunchCooperativeKernel((const void*)hymba_fwd, dim3(grid), dim3(512), args, LDS_BYTES, stream);
    if (e != hipSuccess) fprintf(stderr, "cooperative launch failed: %s (grid %d)\n", hipGetErrorString(e), grid);
}
```

```cpp
#include <hip/hip_runtime.h>
#include <hip/hip_cooperative_groups.h>
#include <cstdio>
#include <cstdint>
namespace cg = cooperative_groups;
__device__ __forceinline__ int fresh_tid() { int t = threadIdx.x; asm volatile("" : "+v"(t)); return t; }
__device__ __forceinline__ int fresh_bid() { int t = blockIdx.x; asm volatile("" : "+s"(t)); return t; }
#define LAS __attribute__((address_space(3)))
#define XB_TMO      128
#define XB_XCNT(j)  (256  + 64 * (j))
#define XB_XSUB(j)  (1280 + 64 * (j))
#define XB_XGEN(j)  (2304 + 64 * (j))
#define XB_TOP      3328
#define XB_TOPGEN   3392
#define XCD_BAR_WORDS 3456
#define XB_SPIN_CAP (1u << 18)

__device__ __forceinline__ unsigned xb_ld(unsigned* p)              { return __hip_atomic_load(p, __ATOMIC_RELAXED, __HIP_MEMORY_SCOPE_AGENT); }
__device__ __forceinline__ unsigned xb_add(unsigned* p, unsigned v) { return __hip_atomic_fetch_add(p, v, __ATOMIC_RELAXED, __HIP_MEMORY_SCOPE_AGENT); }
__device__ __forceinline__ unsigned xb_xcc_id() { return (unsigned)__builtin_amdgcn_s_getreg((3 << 11) | 20) & 0xFu; }
#define XB_SPIN(cond, bar) do { unsigned _sp = 0; while (cond) { __builtin_amdgcn_s_sleep(1); \
    if ((++_sp & 255u) == 0u) { if (xb_ld(&(bar)[XB_TMO])) break; if (_sp > XB_SPIN_CAP) { atomicAdd(&(bar)[XB_TMO], 1u); break; } } } } while (0)

struct XcdBarrier {
    unsigned* bar; unsigned x;
    volatile LAS unsigned* st;
};

__device__ __forceinline__ XcdBarrier xcd_barrier_post(unsigned* bar, volatile LAS unsigned* st) {
    XcdBarrier b; b.bar = bar; b.x = xb_xcc_id(); b.st = st;
    if (threadIdx.x == 0) (void)xb_add(&bar[XB_XCNT(b.x)], 1u);
    return b;
}
__device__ __forceinline__ void xcd_barrier_complete(unsigned* bar, unsigned x, unsigned& nloc, unsigned& nx) {
    const unsigned G = gridDim.x * gridDim.y * gridDim.z;
    unsigned sum, cnt, mine, sp = 0u;
    for (;;) {
        sum = 0u; cnt = 0u; mine = 0u;
#pragma unroll
        for (unsigned j = 0; j < 16; ++j) { const unsigned c = xb_ld(&bar[XB_XCNT(j)]); sum += c; cnt += (c > 0u) ? 1u : 0u; mine = (j == x) ? c : mine; }
        if (sum == G) break;
        __builtin_amdgcn_s_sleep(1);
        if ((++sp & 255u) == 0u) { if (xb_ld(&bar[XB_TMO])) break; if (sp > XB_SPIN_CAP) { atomicAdd(&bar[XB_TMO], 1u); break; } }
    }
    nloc = mine > 0u ? mine : 1u; nx = cnt > 0u ? cnt : 1u;
}

__device__ __forceinline__ void xcd_barrier(const XcdBarrier& b) {
    asm volatile("s_waitcnt vmcnt(0)" ::: "memory");
    __syncthreads();
    if (threadIdx.x == 0) {
        unsigned* bar = b.bar;
        __builtin_amdgcn_s_waitcnt(0);
        unsigned nloc = b.st[0], nx = b.st[1];
        if (nloc == 0u) { xcd_barrier_complete(bar, b.x, nloc, nx); b.st[0] = nloc; b.st[1] = nx; }
        const unsigned old = xb_add(&bar[XB_XSUB(b.x)], 1u);
        const unsigned gen = old / nloc;
        if (old + 1u == (gen + 1u) * nloc) {
            __builtin_amdgcn_fence(__ATOMIC_RELEASE, "agent");
            asm volatile("s_waitcnt vmcnt(0)" ::: "memory");
            const unsigned og = xb_add(&bar[XB_TOP], 1u);
            const unsigned tg = og / nx;
            if (og + 1u == (tg + 1u) * nx) xb_add(&bar[XB_TOPGEN], 1u);
            else XB_SPIN(xb_ld(&bar[XB_TOPGEN]) == tg, bar);
            __builtin_amdgcn_fence(__ATOMIC_ACQUIRE, "agent");
            xb_add(&bar[XB_XGEN(b.x)], 1u);
            asm volatile("s_waitcnt vmcnt(0)" ::: "memory");
        } else {
            XB_SPIN(xb_ld(&bar[XB_XGEN(b.x)]) == gen, bar);
            __builtin_amdgcn_fence(__ATOMIC_ACQUIRE, "agent");
            asm volatile("s_waitcnt vmcnt(0)" ::: "memory");
        }
    }
    __syncthreads();
}
namespace pg8 {
#define PG8_LAS __attribute__((address_space(3)))
typedef unsigned short bf16_t;
typedef short bf16x8 __attribute__((ext_vector_type(8)));
typedef float f32x4 __attribute__((ext_vector_type(4)));
typedef unsigned u32x4 __attribute__((ext_vector_type(4)));
constexpr int BM = 256, BK = 64, HALF = 128, HTB = HALF * BK * 2  , STAGE_BYTES = 8 * HTB, NXCD = 8, WGM = 8;

__host__ __device__ __forceinline__ int lds_byte(int r, int c) { const int st = (r >> 4) * 2 + (c >> 5), rr = r & 15, cc = c & 31, ob = rr * 64 + cc * 2; return st * 1024 + (ob ^ (((ob >> 9) & 1) << 5)); }
__host__ __device__ __forceinline__ void stage_rc(int b, int& R, int& C) { const int st = b / 1024, sb = b % 1024, swz = sb ^ (((sb >> 9) & 1) << 5); R = (st >> 1) * 16 + swz / 64; C = (st & 1) * 32 + (swz % 64) / 2; }
__host__ __device__ __forceinline__ int perm32(int rho) { const int n = rho >> 4, i = rho & 15; return 8 * (i >> 2) + 4 * n + (i & 3); }

struct Unit { int pm, pn; };
struct Gemm { const bf16_t* A; const bf16_t* Bt; int M, N, K; };

struct StaticOrder {
    int nM, nN, nwg, G, c;
    __host__ __device__ void init(int M, int N, int G_, int c_) { nM = M / BM; nN = N / BM; nwg = nM * nN; G = G_; c = c_; }
    __host__ __device__ bool next(int i, Unit& u) const {
        const long L = (long)i * G + c; if (L >= nwg) return false;
        int wgid = (int)L; { const int q = nwg / NXCD, r = nwg % NXCD, xcd = wgid % NXCD, off = wgid / NXCD; wgid = (xcd < r ? xcd * (q + 1) : r * (q + 1) + (xcd - r) * q) + off; }
        const int nig = WGM * nN, gid = wgid / nig, fm = gid * WGM, gsz = (nM - fm) < WGM ? (nM - fm) : WGM;
        u.pm = fm + ((wgid % nig) % gsz); u.pn = (wgid % nig) / gsz; return true;
    }
    __device__ __forceinline__ void a_ready(const Unit&) const {}
    __device__ __forceinline__ void done(const Unit&) const {}
};

__device__ __forceinline__ unsigned cvt_pk_bf16(float lo, float hi) { unsigned r; asm volatile("v_cvt_pk_bf16_f32 %0, %1, %2" : "=v"(r) : "v"(lo), "v"(hi)); return r; }
typedef float f32x2 __attribute__((ext_vector_type(2)));
template <class Epi, class Sched, bool ALIGN_EPI = false, bool SP2 = false>
__device__ __forceinline__ void gemm_phase(PG8_LAS unsigned char* lds, const Gemm g, const Sched& S, const Epi& E) {
    const int tid = fresh_tid(), wid = __builtin_amdgcn_readfirstlane(tid >> 6), lane = tid & 63, wr = wid >> 2, wc = wid & 3, fr = lane & 15, fq = lane >> 4;
    const int K = g.K, nt = K / BK;
    unsigned voffA[2], voffB[2];
#pragma unroll
    for (int i = 0; i < 2; ++i) { int R, C; stage_rc(tid * 16 + i * 8192, R, C); const int Rb = Epi::PERM ? ((R & ~31) + perm32(R & 31)) : R;
        voffA[i] = (unsigned)(R * K + C) * 2u; voffB[i] = (unsigned)(Rb * K + C) * 2u; }
    const size_t kstep = (size_t)(BK * 2);
    const size_t hstep = (size_t)HALF * K * 2;
    const size_t tstep = 2 * hstep;
    const unsigned ldsw = (unsigned)wid * 1024u;
    const int aoff = lds_byte(wr * 64 + fr, fq * 8), boff = lds_byte(wc * 32 + fr, fq * 8);
#define PG8_SA(b, h) (((b) * 2 + (h)) * HTB)
#define PG8_SB(b, h) ((4 + (b) * 2 + (h)) * HTB)
#define PG8_STAGE(bufoff, gbase, voff) do { _Pragma("unroll") for (int _i = 0; _i < 2; ++_i) \
        __builtin_amdgcn_global_load_lds((const unsigned*)((const char*)(gbase) + (voff)[_i]), (PG8_LAS unsigned*)(lds + (bufoff) + ldsw + _i * 8192), 16, 0, 0); } while (0)
#define PG8_LDA(dst, b, h) do { _Pragma("unroll") for (int m = 0; m < 4; ++m) _Pragma("unroll") for (int k = 0; k < 2; ++k) dst[m][k] = *(const PG8_LAS bf16x8*)(lds + PG8_SA(b, h) + aoff + m * 2048 + k * 1024); } while (0)
#define PG8_LDB(dst, b, h) do { _Pragma("unroll") for (int n = 0; n < 2; ++n) _Pragma("unroll") for (int k = 0; k < 2; ++k) dst[n][k] = *(const PG8_LAS bf16x8*)(lds + PG8_SB(b, h) + boff + n * 2048 + k * 1024); } while (0)
#define PG8_MMA(ai, bj, At, Bt) do { __builtin_amdgcn_s_setprio(1); _Pragma("unroll") for (int m = 0; m < 4; ++m) _Pragma("unroll") for (int n = 0; n < 2; ++n) _Pragma("unroll") for (int k = 0; k < 2; ++k) \
        acc[ai][bj][m][n] = __builtin_amdgcn_mfma_f32_16x16x32_bf16(Bt[n][k], At[m][k], acc[ai][bj][m][n], 0, 0, 0); __builtin_amdgcn_s_setprio(0); } while (0)
#define PG8_WAIT_V(n) asm volatile("s_waitcnt vmcnt(" #n ")" ::: "memory")
#define PG8_WAIT_L(n) asm volatile("s_waitcnt lgkmcnt(" #n ")" ::: "memory")
#define PG8_BAR __builtin_amdgcn_s_barrier()
#define PG8_SCHED __builtin_amdgcn_sched_barrier(0)
    Unit cur, nxt; int ui = 0;
    if (!S.next(0, cur)) return;
    f32x4 acc[2][2][4][2];
#pragma unroll
    for (int a = 0; a < 2; ++a)
#pragma unroll
        for (int b = 0; b < 2; ++b)
#pragma unroll
            for (int m = 0; m < 4; ++m)
#pragma unroll
                for (int n = 0; n < 2; ++n) acc[a][b][m][n] = (f32x4){0.f, 0.f, 0.f, 0.f};
    bf16x8 At[4][2], B0[2][2], B1[2][2];
    const char* cA = (const char*)g.A + (size_t)cur.pm * tstep; const char* cB = (const char*)g.Bt + (size_t)cur.pn * tstep;
    S.a_ready(cur);
    if constexpr (SP2) {
        PG8_STAGE(PG8_SB(0, 0), cB, voffB); PG8_STAGE(PG8_SB(0, 1), cB + hstep, voffB); PG8_STAGE(PG8_SA(0, 0), cA, voffA); PG8_STAGE(PG8_SA(0, 1), cA + hstep, voffA);
        if (wr == 1) PG8_BAR;
        PG8_WAIT_V(2); PG8_BAR;
        PG8_STAGE(PG8_SB(1, 0), cB + kstep, voffB); PG8_STAGE(PG8_SA(1, 0), cA + kstep, voffA); PG8_STAGE(PG8_SB(1, 1), cB + hstep + kstep, voffB);
        PG8_WAIT_V(6); PG8_BAR;
    } else {
        PG8_STAGE(PG8_SB(0, 0), cB, voffB); PG8_STAGE(PG8_SA(0, 0), cA, voffA); PG8_STAGE(PG8_SB(0, 1), cB + hstep, voffB); PG8_STAGE(PG8_SA(0, 1), cA + hstep, voffA);
        if (wr == 1) PG8_BAR;
        PG8_WAIT_V(4); PG8_BAR;
        PG8_STAGE(PG8_SB(1, 0), cB + kstep, voffB); PG8_STAGE(PG8_SA(1, 0), cA + kstep, voffA); PG8_STAGE(PG8_SB(1, 1), cB + hstep + kstep, voffB);
        PG8_WAIT_V(6); PG8_BAR;
    }
    for (;;) {
        const bool has_next = S.next(ui + 1, nxt);
        const char* nA = has_next ? (const char*)g.A + (size_t)nxt.pm * tstep : cA; const char* nB = has_next ? (const char*)g.Bt + (size_t)nxt.pn * tstep : cB;
        for (int t = 0; t < nt; t += 2) {
            const bool last = (t == nt - 2);
            const char* a1 = cA + (size_t)(t + 1) * kstep;
            const char* a2 = last ? nA : cA + (size_t)(t + 2) * kstep; const char* b2 = last ? nB : cB + (size_t)(t + 2) * kstep;
            const char* a3 = a2 + kstep; const char* b3 = b2 + kstep;
            if (last && has_next) S.a_ready(nxt);
            if constexpr (SP2) {
            PG8_LDB(B0, 0, 0); PG8_LDB(B1, 0, 1); PG8_SCHED; PG8_LDA(At, 0, 0); PG8_STAGE(PG8_SA(1, 1), a1 + hstep, voffA);
            PG8_WAIT_V(8); PG8_WAIT_L(0); PG8_BAR; PG8_MMA(0, 0, At, B0); PG8_MMA(0, 1, At, B1); PG8_BAR; PG8_SCHED;
            PG8_LDA(At, 0, 1); PG8_STAGE(PG8_SB(0, 0), b2, voffB); PG8_STAGE(PG8_SB(0, 1), b2 + hstep, voffB); PG8_STAGE(PG8_SA(0, 0), a2, voffA);
            PG8_WAIT_V(8); PG8_WAIT_L(0); PG8_BAR; PG8_MMA(1, 0, At, B0); PG8_MMA(1, 1, At, B1); PG8_BAR; PG8_SCHED;
            PG8_LDB(B0, 1, 0); PG8_LDB(B1, 1, 1); PG8_SCHED; PG8_LDA(At, 1, 0); PG8_STAGE(PG8_SA(0, 1), a2 + hstep, voffA);
            PG8_WAIT_V(8); PG8_WAIT_L(0); PG8_BAR; PG8_MMA(0, 0, At, B0); PG8_MMA(0, 1, At, B1); PG8_BAR; PG8_SCHED;
            PG8_LDA(At, 1, 1); PG8_STAGE(PG8_SB(1, 0), b3, voffB); PG8_STAGE(PG8_SB(1, 1), b3 + hstep, voffB); PG8_STAGE(PG8_SA(1, 0), a3, voffA);
            PG8_WAIT_V(8); PG8_WAIT_L(0); PG8_BAR; PG8_MMA(1, 0, At, B0); PG8_MMA(1, 1, At, B1); PG8_BAR; PG8_SCHED;
            } else {
            PG8_LDB(B0, 0, 0); PG8_SCHED; PG8_LDA(At, 0, 0); PG8_STAGE(PG8_SA(1, 1), a1 + hstep, voffA);
            PG8_WAIT_L(8); PG8_BAR; PG8_WAIT_L(0); PG8_MMA(0, 0, At, B0); PG8_BAR; PG8_SCHED;
            PG8_LDB(B1, 0, 1); PG8_STAGE(PG8_SB(0, 0), b2, voffB);
            PG8_BAR; PG8_WAIT_L(0); PG8_MMA(0, 1, At, B1); PG8_BAR;
            PG8_LDA(At, 0, 1); PG8_STAGE(PG8_SA(0, 0), a2, voffA);
            PG8_BAR; PG8_WAIT_L(0); PG8_MMA(1, 0, At, B0); PG8_BAR; PG8_SCHED;
            PG8_STAGE(PG8_SB(0, 1), b2 + hstep, voffB);
            PG8_WAIT_V(6); PG8_BAR; PG8_MMA(1, 1, At, B1); PG8_BAR;
            PG8_LDB(B0, 1, 0); PG8_SCHED; PG8_LDA(At, 1, 0); PG8_STAGE(PG8_SA(0, 1), a2 + hstep, voffA);
            PG8_WAIT_L(8); PG8_BAR; PG8_WAIT_L(0); PG8_MMA(0, 0, At, B0); PG8_BAR; PG8_SCHED;
            PG8_LDB(B1, 1, 1); PG8_STAGE(PG8_SB(1, 0), b3, voffB);
            PG8_BAR; PG8_WAIT_L(0); PG8_MMA(0, 1, At, B1); PG8_BAR;
            PG8_LDA(At, 1, 1); PG8_STAGE(PG8_SA(1, 0), a3, voffA);
            PG8_BAR; PG8_WAIT_L(0); PG8_MMA(1, 0, At, B0); PG8_BAR; PG8_SCHED;
            PG8_STAGE(PG8_SB(1, 1), b3 + hstep, voffB);
            PG8_WAIT_V(6); PG8_BAR; PG8_MMA(1, 1, At, B1); PG8_BAR;
            }
        }
        if constexpr (ALIGN_EPI) { if (wr == 0) PG8_BAR; }
        if constexpr (!Epi::AFTER_DRAIN) { E(acc, cur, wr, wc, fr, fq); S.done(cur); }
        if (!has_next) break;
#pragma unroll
        for (int a = 0; a < 2; ++a)
#pragma unroll
            for (int b = 0; b < 2; ++b)
#pragma unroll
                for (int m = 0; m < 4; ++m)
#pragma unroll
                    for (int n = 0; n < 2; ++n) acc[a][b][m][n] = (f32x4){0.f, 0.f, 0.f, 0.f};
        cur = nxt; cA = nA; cB = nB; ++ui;
        if constexpr (ALIGN_EPI) { if (wr == 1) PG8_BAR; }
    }
    PG8_WAIT_V(0);
    if constexpr (!ALIGN_EPI) { if (wr == 0) PG8_BAR; }
    PG8_BAR;
    if constexpr (Epi::AFTER_DRAIN) { E.fused(acc, cur, wr, wc, fr, fq, lds, wid, lane); S.done(cur); }
#undef PG8_SA
#undef PG8_SB
#undef PG8_STAGE
#undef PG8_LDA
#undef PG8_LDB
#undef PG8_MMA
#undef PG8_WAIT_V
#undef PG8_WAIT_L
#undef PG8_BAR
#undef PG8_SCHED
}
}
namespace pg8 {
typedef __bf16 bf16x2_t __attribute__((ext_vector_type(2)));
__device__ __forceinline__ unsigned pkbf(float lo, float hi) { f32x2 v = {lo, hi}; bf16x2_t b = __builtin_convertvector(v, bf16x2_t); return __builtin_bit_cast(unsigned, b); }
typedef unsigned u32x2 __attribute__((ext_vector_type(2)));

struct EpiProj {
    static constexpr bool PERM = true, AFTER_DRAIN = false;
    bf16_t* O; int ldc; const float* ss;
    __device__ __forceinline__ void operator()(const f32x4 (&acc)[2][2][4][2], const Unit& u, int wr, int wc, int fr, int fq) const {
        const int row0 = u.pm * BM + wr * 64 + fr; const int col0 = u.pn * BM + wc * 32 + 8 * fq;
#pragma unroll
        for (int ai = 0; ai < 2; ++ai) {
            f32x4 sq[4];
#pragma unroll
            for (int m = 0; m < 4; ++m) sq[m] = ((const f32x4*)(ss + (size_t)(row0 + ai * HALF + m * 16) * 16))[fq];
#pragma unroll
            for (int m = 0; m < 4; ++m) {
                const int row = row0 + ai * HALF + m * 16;
                float st_ = (sq[m][0] + sq[m][1]) + (sq[m][2] + sq[m][3]); st_ += __shfl_xor(st_, 16); st_ += __shfl_xor(st_, 32);
                const float rs = rsqrtf(st_ * (1.0f / 1024.0f) + 1e-6f);
                bf16_t* rowp = O + (size_t)row * ldc + col0;
#pragma unroll
                for (int bj = 0; bj < 2; ++bj) {
                    const f32x4 v0 = acc[ai][bj][m][0] * rs, v1 = acc[ai][bj][m][1] * rs;
                    u32x4 w; w.x = pkbf(v0[0], v0[1]); w.y = pkbf(v0[2], v0[3]); w.z = pkbf(v1[0], v1[1]); w.w = pkbf(v1[2], v1[3]);
                    *(u32x4*)(rowp + bj * HALF) = w;
                }
            }
            asm volatile("" ::: "memory");
        }
    }
};

struct EpiSwiglu {
    static constexpr bool PERM = true, AFTER_DRAIN = false;
    bf16_t* O; int ldc; const float* ss;
    __device__ __forceinline__ void operator()(const f32x4 (&acc)[2][2][4][2], const Unit& u, int wr, int wc, int fr, int fq) const {
        const int row0 = u.pm * BM + wr * 64 + fr; const int col0 = u.pn * HALF + wc * 32 + 8 * fq;
#pragma unroll
        for (int ai = 0; ai < 2; ++ai) {
            f32x4 sq[4];
#pragma unroll
            for (int m = 0; m < 4; ++m) sq[m] = ((const f32x4*)(ss + (size_t)(row0 + ai * HALF + m * 16) * 16))[fq];
#pragma unroll
            for (int m = 0; m < 4; ++m) {
                const int row = row0 + ai * HALF + m * 16;
                float st_ = (sq[m][0] + sq[m][1]) + (sq[m][2] + sq[m][3]); st_ += __shfl_xor(st_, 16); st_ += __shfl_xor(st_, 32);
                const float rs = rsqrtf(st_ * (1.0f / 1024.0f) + 1e-6f);
                float o[8];
#pragma unroll
                for (int n = 0; n < 2; ++n)
#pragma unroll
                    for (int i = 0; i < 4; ++i) {
                        const float g = acc[ai][0][m][n][i] * rs, up = acc[ai][1][m][n][i] * rs;
                        const float sg = g * __builtin_amdgcn_rcpf(1.0f + __expf(-g));
                        o[4 * n + i] = sg * up;
                    }
                u32x4 w; w.x = pkbf(o[0], o[1]); w.y = pkbf(o[2], o[3]); w.z = pkbf(o[4], o[5]); w.w = pkbf(o[6], o[7]);
                *(u32x4*)(O + (size_t)row * ldc + col0) = w;
            }
            asm volatile("" ::: "memory");
        }
    }
};

template <bool RESF32, bool OUTF32> struct EpiRes {
    static constexpr bool PERM = true, AFTER_DRAIN = false;
    const float* resA; const float* resB; int splitRow;
    float* X; bf16_t* XN; float* ssout;
    __device__ __forceinline__ void operator()(const f32x4 (&acc)[2][2][4][2], const Unit& u, int wr, int wc, int fr, int fq) const {
        const int col0 = u.pn * BM + wc * 32 + 8 * fq;
        const int trow = u.pm * BM;
        const float* rbase = nullptr;
        if constexpr (RESF32) rbase = (trow < splitRow) ? (resA + (size_t)trow * 1024) : (resB + (size_t)(trow - splitRow) * 1024);
#pragma unroll
        for (int ai = 0; ai < 2; ++ai)
#pragma unroll
            for (int m = 0; m < 4; ++m) {
                const int lr = ai * HALF + wr * 64 + m * 16 + fr;
                const size_t off = (size_t)(trow + lr) * 1024 + col0;
                float s = 0.f;
#pragma unroll
                for (int bj = 0; bj < 2; ++bj) {
                    f32x4 r0, r1;
                    if constexpr (RESF32) { r0 = *(const f32x4*)(rbase + (size_t)lr * 1024 + col0 + bj * HALF); r1 = *(const f32x4*)(rbase + (size_t)lr * 1024 + col0 + bj * HALF + 4); }
                    else { const u32x4 w = *(const u32x4*)(XN + off + bj * HALF);
                        r0 = (f32x4){__uint_as_float(w.x << 16), __uint_as_float(w.x & 0xffff0000u), __uint_as_float(w.y << 16), __uint_as_float(w.y & 0xffff0000u)};
                        r1 = (f32x4){__uint_as_float(w.z << 16), __uint_as_float(w.z & 0xffff0000u), __uint_as_float(w.w << 16), __uint_as_float(w.w & 0xffff0000u)}; }
                    const f32x4 v0 = r0 + acc[ai][bj][m][0], v1 = r1 + acc[ai][bj][m][1];
                    if constexpr (OUTF32) { __builtin_nontemporal_store(v0, (f32x4*)(X + off + bj * HALF)); __builtin_nontemporal_store(v1, (f32x4*)(X + off + bj * HALF + 4)); }
                    else { u32x4 w; w.x = pkbf(v0[0], v0[1]); w.y = pkbf(v0[2], v0[3]); w.z = pkbf(v1[0], v1[1]); w.w = pkbf(v1[2], v1[3]); *(u32x4*)(XN + off + bj * HALF) = w; }
                    s += ((v0[0] * v0[0] + v0[1] * v0[1]) + (v0[2] * v0[2] + v0[3] * v0[3])) + ((v1[0] * v1[0] + v1[1] * v1[1]) + (v1[2] * v1[2] + v1[3] * v1[3]));
                }
                s += __shfl_xor(s, 16); s += __shfl_xor(s, 32);
                if (fq == 0) ssout[(size_t)(trow + lr) * 16 + u.pn * 4 + wc] = s;
                if (m == 3) asm volatile("" ::: "memory");
            }
    }
};
}

constexpr int DM = 1024, SEQ = 16384, DEPTH = 4, DECB = 32, DECS = 64, PAST = 2048;
constexpr int MROWS = SEQ + DECB * DECS;
constexpr int DA = 512, DPB = 256, DCC = 256, DIN = 2048, DFF = 2816;
constexpr int NCH = MROWS / 64;
constexpr int NPCH = SEQ / 64;
constexpr float LOG2E = 1.4426950408889634f;

constexpr size_t O_Y = 0;
constexpr size_t O_KP = 18874368, O_VP = 35651584, O_CONVP = 52428800, O_LRUP = 52434944, O_POOLP = 52436992;
constexpr size_t O_KS = 52452352, O_VS = 54549504, O_CONVS = 56646656, O_LRUS = 56843264, O_POOLS = 56908800, O_END = 57400320;

constexpr size_t MiB = 1u << 20;
constexpr size_t WS_BAR = 0;
constexpr size_t WS_SS = 430 * MiB;
constexpr size_t WS_GW = 1 * MiB, WS_PWT = 1 * MiB + 512 * 1024;
constexpr size_t WS_WIN = 2 * MiB, WS_WOUT = 18 * MiB, WS_WGU = 26 * MiB, WS_WDN = 70 * MiB;
constexpr size_t WS_XN = 92 * MiB, WS_PROJ = 128 * MiB, WS_MIX = 200 * MiB, WS_ACT = 236 * MiB;
constexpr size_t WS_QB = 336 * MiB, WS_KB = 345 * MiB, WS_PT = 354 * MiB, WS_HL = 390 * MiB, WS_CHA = 426 * MiB, WS_CHH = 427 * MiB, WS_CARRY = 428 * MiB, WS_END = 442 * MiB;
static_assert(WS_ACT + (size_t)MROWS * DFF * 2 <= WS_QB, "ws map");

constexpr int LDS_BYTES = 147456;

#define LAS __attribute__((address_space(3)))
#define DI __device__ __forceinline__
typedef unsigned short bf16;
typedef short bfx8 __attribute__((ext_vector_type(8)));
typedef float fx4 __attribute__((ext_vector_type(4)));
typedef float fx2 __attribute__((ext_vector_type(2)));
typedef float fx16 __attribute__((ext_vector_type(16)));
typedef unsigned ux4 __attribute__((ext_vector_type(4)));
typedef unsigned ux2 __attribute__((ext_vector_type(2)));
typedef __bf16 bf2_t __attribute__((ext_vector_type(2)));

DI unsigned pk2(float lo, float hi) { fx2 v = {lo, hi}; bf2_t b = __builtin_convertvector(v, bf2_t); return __builtin_bit_cast(unsigned, b); }
DI float bf2f(bf16 b) { return __uint_as_float((unsigned)b << 16); }
DI float bflo(unsigned w) { return __uint_as_float(w << 16); }
DI float bfhi(unsigned w) { return __uint_as_float(w & 0xffff0000u); }
DI float sigmoidf_(float x) { return __builtin_amdgcn_rcpf(1.0f + __expf(-x)); }
DI float gelu_tanh(float g) { const float y = 0.7978845608028654f * (g + 0.044715f * g * g * g); const float t = 1.0f - 2.0f * __builtin_amdgcn_rcpf(1.0f + __expf(2.0f * y)); return 0.5f * g * (1.0f + t); }
#define MFMA32(a, b, c) __builtin_amdgcn_mfma_f32_32x32x16_bf16((a), (b), (c), 0, 0, 0)

struct Args { const float* in[25]; float* out; unsigned char* ws; int ph_lo, ph_hi; };
typedef const volatile LAS unsigned long long* Tab;
DI const float* TP(Tab tab, int i) { const unsigned long long v = tab[i]; const unsigned lo = __builtin_amdgcn_readfirstlane((unsigned)v), hi = __builtin_amdgcn_readfirstlane((unsigned)(v >> 32)); return (const float*)(((unsigned long long)hi << 32) | lo); }
#define IN(k) TP(tab, (k))
#define OUTP ((float*)TP(tab, 25))
#define WSP ((unsigned char*)TP(tab, 26))

DI void tr_item(const float* W, int N, bf16* WT, int ldk, const float* gain, LAS float* scr, int k0, int n0, size_t row0, int lane) {
#pragma unroll 8
    for (int i = 0; i < 32; ++i) { const int kk = 2 * i + (lane >> 5); const float g = gain ? gain[k0 + kk] : 1.0f; scr[kk * 33 + (lane & 31)] = W[(size_t)(k0 + kk) * N + n0 + (lane & 31)] * g; }
    asm volatile("s_waitcnt lgkmcnt(0)" ::: "memory");
    const int c = lane & 7;
#pragma unroll
    for (int j = 0; j < 4; ++j) { const int n = (lane >> 3) + 8 * j; const LAS float* s = scr + (8 * c) * 33 + n;
        ux4 o; o.x = pk2(s[0 * 33], s[1 * 33]); o.y = pk2(s[2 * 33], s[3 * 33]); o.z = pk2(s[4 * 33], s[5 * 33]); o.w = pk2(s[6 * 33], s[7 * 33]);
        *(ux4*)(WT + (row0 + n) * (size_t)ldk + k0 + 8 * c) = o; }
    asm volatile("s_waitcnt lgkmcnt(0)" ::: "memory");
}

constexpr int I_IN = 16 * 64, I_OUT = 16 * 32, I_G = 16 * 88, I_D = 44 * 32, I_L = I_IN + I_OUT + 2 * I_G + I_D;
DI void conv_item(Tab tab, int l, int r, LAS float* scr, int lane) {
    const float* W; int N; bf16* WT; int ldk; const float* gain; int k0, n0; size_t row0;
    unsigned char* ws = WSP;
    if (r < I_IN) { const int kb = r / 64, nb = r % 64; W = IN(8) + (size_t)l * DM * DIN; N = DIN; WT = (bf16*)(ws + WS_WIN); ldk = DM; gain = IN(7) + l * DM; k0 = 64 * kb; n0 = 32 * nb; row0 = (size_t)l * DIN + n0; }
    else if (r < I_IN + I_OUT) { r -= I_IN; const int kb = r / 32, nb = r % 32; W = IN(20) + (size_t)l * DM * DM; N = DM; WT = (bf16*)(ws + WS_WOUT); ldk = DM; gain = nullptr; k0 = 64 * kb; n0 = 32 * nb; row0 = (size_t)l * DM + n0; }
    else if (r < I_IN + I_OUT + 2 * I_G) { r -= I_IN + I_OUT; const int up = r >= I_G; if (up) r -= I_G; const int kb = r / 88, nb = r % 88;
        W = IN(up ? 23 : 22) + (size_t)l * DM * DFF; N = DFF; WT = (bf16*)(ws + WS_WGU); ldk = DM; gain = IN(21) + l * DM; k0 = 64 * kb; n0 = 32 * nb;
        row0 = (size_t)l * 5632 + 256 * (n0 / 128) + (n0 % 128) + (up ? 128 : 0); }
    else { r -= I_IN + I_OUT + 2 * I_G; const int kb = r / 32, nb = r % 32; W = IN(24) + (size_t)l * DFF * DM; N = DM; WT = (bf16*)(ws + WS_WDN); ldk = DFF; gain = nullptr; k0 = 64 * kb; n0 = 32 * nb; row0 = (size_t)l * DM + n0; }
    tr_item(W, N, WT, ldk, gain, scr, k0, n0, row0, lane);
}
DI void conv_layer_dyn(Tab tab, LAS unsigned char* lds, int l) {
    const int tid = fresh_tid(), lane = tid & 63, wave = tid >> 6;
    LAS float* scr = (LAS float*)(lds + wave * 8704);
    unsigned* ctr = (unsigned*)(WSP + WS_BAR + 49152) + l * 64;
    for (;;) {
        unsigned base = 0;
        if (lane == 0) base = __hip_atomic_fetch_add(ctr, 4u, __ATOMIC_RELAXED, __HIP_MEMORY_SCOPE_AGENT);
        base = (unsigned)__builtin_amdgcn_readfirstlane((int)base);
        if (base >= (unsigned)I_L) break;
        for (int j = 0; j < 4; ++j) if ((int)base + j < I_L) conv_item(tab, l, (int)base + j, scr, lane);
    }
}

DI void prologue(Tab tab, LAS unsigned char* lds) {
    const int tid = fresh_tid(), lane = tid & 63, wave = tid >> 6;
    const int G = gridDim.x, gw = fresh_bid() * 8 + wave, NGW = G * 8;
    LAS float* scr = (LAS float*)(lds + wave * 8704);
    for (int it = gw; it < I_L; it += NGW) conv_item(tab, 0, it, scr, lane);
    for (int it = gw; it < 2 * 144; it += NGW) {
        const int mi = it >> 1, n0 = 32 * (it & 1);
        const float* W; bf16* WT;
        if (mi < 64) { const int ll = mi >> 3, hb = mi & 7; W = IN(11) + (size_t)mi * 4096; WT = (bf16*)(WSP + WS_GW) + (size_t)((ll * 2 + 0) * 8 + hb) * 4096; }
        else if (mi < 128) { const int m2 = mi - 64, ll = m2 >> 3, hb = m2 & 7; W = IN(13) + (size_t)m2 * 4096; WT = (bf16*)(WSP + WS_GW) + (size_t)((ll * 2 + 1) * 8 + hb) * 4096; }
        else { const int m2 = mi - 128; W = IN(16) + (size_t)m2 * 4096; WT = (bf16*)(WSP + WS_PWT) + (size_t)m2 * 4096; }
        tr_item(W, 64, WT, 64, nullptr, scr, 0, n0, (size_t)n0, lane);
    }
    {
        bf16* XN = (bf16*)(WSP + WS_XN); float* SS = (float*)(WSP + WS_SS);
        const float* xp = IN(0); const float* xs = IN(1);
        for (int row = gw; row < MROWS; row += NGW) {
            const float* xr = row < SEQ ? xp + (size_t)row * DM : xs + (size_t)(row - SEQ) * DM;
            float s = 0.f;
#pragma unroll
            for (int j = 0; j < 4; ++j) { const fx4 v = *(const fx4*)(xr + 4 * lane + 256 * j); s += (v.x * v.x + v.y * v.y) + (v.z * v.z + v.w * v.w);
                ux2 w; w.x = pk2(v.x, v.y); w.y = pk2(v.z, v.w); *(ux2*)(XN + (size_t)row * DM + 4 * lane + 256 * j) = w; }
#pragma unroll
            for (int o = 1; o < 64; o <<= 1) s += __shfl_xor(s, o);
            if (lane < 16) SS[(size_t)row * 16 + lane] = lane == 0 ? s : 0.f;
        }
    }
}

DI void mixA_lru(Tab tab, LAS unsigned char* lds, int l, int c, int hb) {
    LAS float* XA = (LAS float*)lds;
    LAS bf16* XCB = (LAS bf16*)(lds + 17152);
    LAS float* GT = (LAS float*)(lds + 26368);
    LAS float* SUM = (LAS float*)(lds + 59136);
    const int tid = fresh_tid(), ch = tid & 63, tg = tid >> 6, lane = tid & 63, r = lane & 31, h = lane >> 5;
    const int gate = tg >> 2, th = (tg >> 1) & 1, jh = tg & 1;
    const bool samp = c >= NPCH; const int b = c - NPCH;
    const bf16* proj = (const bf16*)(WSP + WS_PROJ);
    const int gch = 64 * hb + ch;
    const float cb = IN(10)[l * DA + gch];
    float cw[4]; { const float* cwp = IN(9);
#pragma unroll
      for (int j = 0; j < 4; ++j) cw[j] = cwp[(size_t)(l * 4 + j) * DA + gch]; }
    const float ba = IN(12)[(l * 8 + hb) * 64 + ch], bx = IN(14)[(l * 8 + hb) * 64 + ch];
    const float lam = IN(15)[l * DA + gch];
    bfx8 bfrag[4];
    { const bf16* gw = (const bf16*)(WSP + WS_GW) + (size_t)((l * 2 + gate) * 8 + hb) * 4096 + (32 * jh + r) * 64 + 8 * h;
#pragma unroll
      for (int s = 0; s < 4; ++s) bfrag[s] = *(const bfx8*)(gw + 16 * s); }
    {
        const bool halo_proj = !samp && c > 0;
        ux4 pv[2]; bool pok[2];
#pragma unroll
        for (int i = 0; i < 2; ++i) { const int e = tid + 512 * i, rr = e >> 3, t = rr - 3; pok[i] = (e < 67 * 8) && (t >= 0 || halo_proj);
            if (pok[i]) pv[i] = *(const ux4*)(proj + (size_t)(64 * c + t) * DIN + 64 * hb + 8 * (e & 7)); }
        float hv = 0.f;
        if (samp && tid < 192) hv = IN(4)[((size_t)(l * DECB + b) * 3 + (tid >> 6)) * DA + 64 * hb + (tid & 63)];
#pragma unroll
        for (int i = 0; i < 2; ++i) { const int e = tid + 512 * i;
            if (e < 67 * 8) { LAS float* d = XA + (e >> 3) * 64 + 8 * (e & 7);
                if (pok[i]) { *(LAS fx4*)d = (fx4){bflo(pv[i].x), bfhi(pv[i].x), bflo(pv[i].y), bfhi(pv[i].y)}; *(LAS fx4*)(d + 4) = (fx4){bflo(pv[i].z), bfhi(pv[i].z), bflo(pv[i].w), bfhi(pv[i].w)}; }
                else if (!samp) { *(LAS fx4*)d = (fx4){0.f, 0.f, 0.f, 0.f}; *(LAS fx4*)(d + 4) = (fx4){0.f, 0.f, 0.f, 0.f}; } } }
        if (samp && tid < 192) XA[tid] = hv;
    }
    __syncthreads();
    float xc[8];
    {
#pragma unroll
        for (int tt = 0; tt < 8; ++tt) { const int t = 8 * tg + tt; float v = cb;
#pragma unroll
            for (int j = 0; j < 4; ++j) v += cw[j] * XA[(t + j) * 64 + ch];
            xc[tt] = v; XCB[t * 72 + ch] = (bf16)(pk2(v, 0.f) & 0xffffu); }
        if ((c == NPCH - 1 || samp) && tg == 7) {
            float* o = samp ? OUTP + O_CONVS + (size_t)(l * DECB + b) * 3 * DA : OUTP + O_CONVP + (size_t)l * 3 * DA;
#pragma unroll
            for (int rr = 0; rr < 3; ++rr) o[rr * DA + gch] = XA[(64 + rr) * 64 + ch];
        }
    }
    __syncthreads();
    {
        fx16 acc;
#pragma unroll
        for (int i = 0; i < 16; ++i) acc[i] = 0.f;
#pragma unroll
        for (int s = 0; s < 4; ++s) { const bfx8 af = *(const LAS bfx8*)(XCB + (32 * th + r) * 72 + 16 * s + 8 * h); acc = MFMA32(af, bfrag[s], acc); }
#pragma unroll
        for (int i = 0; i < 16; ++i) GT[gate * 4096 + (32 * th + (i & 3) + 8 * (i >> 2) + 4 * h) * 64 + 32 * jh + r] = acc[i];
    }
    __syncthreads();
    float sp;
    { const float x = __expf(-lam); sp = x < 0.03f ? x * (1.0f + x * (-0.5f + x * (0.33333334f + x * (-0.25f + x * 0.2f)))) : __logf(1.0f + x); }
    float pl[8], hl[8]; float p = 1.f, hh = 0.f;
#pragma unroll
    for (int tt = 0; tt < 8; ++tt) {
        const int t = 8 * tg + tt;
        const float rg = sigmoidf_(GT[t * 64 + ch] + ba), ig = sigmoidf_(GT[4096 + t * 64 + ch] + bx);
        const float la = -8.0f * rg * sp;
        const float at = __expf(la);
        const float y2 = 2.0f * la;
        const float om = y2 > -0.125f ? -y2 * (1.0f + y2 * (0.5f + y2 * (0.16666667f + y2 * (0.041666668f + y2 * (0.008333334f + y2 * 0.0013888889f))))) : 1.0f - __expf(y2);
        const float ut = sqrtf(om) * (ig * xc[tt]);
        hh = at * hh + ut; p = p * at; pl[tt] = p; hl[tt] = hh;
    }
    SUM[(tg * 64 + ch) * 2] = p; SUM[(tg * 64 + ch) * 2 + 1] = hh;
    __syncthreads();
    float Pin = 1.f, Hin = 0.f;
#pragma unroll
    for (int g = 0; g < 8; ++g) { const float ag = SUM[(g * 64 + ch) * 2], hg = SUM[(g * 64 + ch) * 2 + 1]; if (g < tg) { Hin = ag * Hin + hg; Pin = Pin * ag; } }
    unsigned* PH = (unsigned*)(WSP + WS_PT);
#pragma unroll
    for (int tt = 0; tt < 8; ++tt) { const size_t o = (size_t)(64 * c + 8 * tg + tt) * DA + gch; PH[o] = pk2(Pin * pl[tt], pl[tt] * Hin + hl[tt]); }
    if (tg == 7) { ((float*)(WSP + WS_CHA))[c * DA + gch] = Pin * p; ((float*)(WSP + WS_CHH))[c * DA + gch] = p * Hin + hh; }
    __syncthreads();
}

DI void mixA_pool(Tab tab, LAS unsigned char* lds, int l, int c, int g) {
    LAS float* UB = (LAS float*)lds;
    LAS bf16* DB = (LAS bf16*)(lds + 20224);
    LAS float* YT = (LAS float*)(lds + 29440);
    const int tid = fresh_tid(), ch = tid & 63, tg = tid >> 6, lane = tid & 63, r = lane & 31, h = lane >> 5;
    const int kh = tg >> 2, th = (tg >> 1) & 1, jh = tg & 1;
    const bool samp = c >= NPCH; const int b = c - NPCH;
    const bf16* proj = (const bf16*)(WSP + WS_PROJ);
    const int w = 2 << g;
    bfx8 bfrag[2];
    { const float* pw = IN(16) + (size_t)(l * 4 + g) * 4096 + 32 * jh + r;
#pragma unroll
      for (int s = 0; s < 2; ++s) { float f[8];
#pragma unroll
          for (int jj = 0; jj < 8; ++jj) f[jj] = pw[(32 * kh + 16 * s + 8 * h + jj) * 64];
          ux4 o; o.x = pk2(f[0], f[1]); o.y = pk2(f[2], f[3]); o.z = pk2(f[4], f[5]); o.w = pk2(f[6], f[7]); bfrag[s] = __builtin_bit_cast(bfx8, o); } }
    const float sc = IN(17)[l * DPB + 64 * g + ch];
    {
        const bool halo_proj = !samp && c > 0;
        ux4 pv[2]; bool pok[2];
#pragma unroll
        for (int i = 0; i < 2; ++i) { const int e = tid + 512 * i, rr = e >> 3, t = rr - 15; pok[i] = (e < 79 * 8) && (t >= 0 || halo_proj);
            if (pok[i]) pv[i] = *(const ux4*)(proj + (size_t)(64 * c + t) * DIN + 2 * DA + 64 * g + 8 * (e & 7)); }
        float hv[2] = {0.f, 0.f};
        if (samp) { const float* spool = IN(6);
#pragma unroll
            for (int i = 0; i < 2; ++i) { const int e = tid + 512 * i; if (e < 15 * 64) hv[i] = spool[((size_t)(l * DECB + b) * 15 + (e >> 6)) * DPB + 64 * g + (e & 63)]; } }
#pragma unroll
        for (int i = 0; i < 2; ++i) { const int e = tid + 512 * i;
            if (e < 79 * 8) { LAS float* d = UB + (e >> 3) * 64 + 8 * (e & 7);
                if (pok[i]) { *(LAS fx4*)d = (fx4){bflo(pv[i].x), bfhi(pv[i].x), bflo(pv[i].y), bfhi(pv[i].y)}; *(LAS fx4*)(d + 4) = (fx4){bflo(pv[i].z), bfhi(pv[i].z), bflo(pv[i].w), bfhi(pv[i].w)}; }
                else if (!samp) { *(LAS fx4*)d = (fx4){0.f, 0.f, 0.f, 0.f}; *(LAS fx4*)(d + 4) = (fx4){0.f, 0.f, 0.f, 0.f}; } } }
        if (samp) {
#pragma unroll
            for (int i = 0; i < 2; ++i) { const int e = tid + 512 * i; if (e < 15 * 64) UB[e] = hv[i]; } }
    }
    __syncthreads();
#pragma unroll
    for (int tt = 0; tt < 8; ++tt) { const int t = 8 * tg + tt; float s = 0.f;
        for (int j = 0; j < w; ++j) s += UB[(15 + t - j) * 64 + ch];
        const int pos1 = samp ? (PAST + t + 1) : (64 * c + t + 1);
        const float cnt = (float)(pos1 < w ? pos1 : w);
        DB[t * 72 + ch] = (bf16)(pk2(s / cnt - UB[(15 + t) * 64 + ch], 0.f) & 0xffffu); }
    if (c == NPCH - 1 || samp) {
        float* o = samp ? OUTP + O_POOLS + (size_t)(l * DECB + b) * 15 * DPB : OUTP + O_POOLP + (size_t)l * 15 * DPB;
        for (int e = tid; e < 15 * 64; e += 512) { const int rr = e >> 6, cc = e & 63; o[rr * DPB + 64 * g + cc] = UB[(64 + rr) * 64 + cc]; }
    }
    __syncthreads();
    fx16 acc;
#pragma unroll
    for (int i = 0; i < 16; ++i) acc[i] = 0.f;
#pragma unroll
    for (int s = 0; s < 2; ++s) { const bfx8 af = *(const LAS bfx8*)(DB + (32 * th + r) * 72 + 32 * kh + 16 * s + 8 * h); acc = MFMA32(af, bfrag[s], acc); }
    if (kh == 0) {
#pragma unroll
        for (int i = 0; i < 16; ++i) YT[(32 * th + (i & 3) + 8 * (i >> 2) + 4 * h) * 64 + 32 * jh + r] = acc[i]; }
    __syncthreads();
    if (kh == 1) {
#pragma unroll
        for (int i = 0; i < 16; ++i) YT[(32 * th + (i & 3) + 8 * (i >> 2) + 4 * h) * 64 + 32 * jh + r] += acc[i]; }
    __syncthreads();
    bf16* mixed = (bf16*)(WSP + WS_MIX);
#pragma unroll
    for (int tt = 0; tt < 8; ++tt) mixed[(size_t)(64 * c + 8 * tg + tt) * DM + DA + 64 * g + ch] = (bf16)(pk2(YT[(8 * tg + tt) * 64 + ch] * sc, 0.f) & 0xffffu);
    __syncthreads();
}

DI void mixA_qk(Tab tab, int l, int c) {
    const int tid = fresh_tid();
    const bf16* proj = (const bf16*)(WSP + WS_PROJ);
    const bool samp = c >= NPCH;
    {
        const int t = tid >> 3, head = (tid >> 1) & 3, which = tid & 1;
        const size_t row = (size_t)64 * c + t;
        const bf16* src = proj + row * DIN + 1280 + which * 256 + 64 * head;
        ux4 v[8]; float s = 0.f;
#pragma unroll
        for (int j = 0; j < 8; ++j) { v[j] = *(const ux4*)(src + 8 * j);
#pragma unroll
            for (int q = 0; q < 4; ++q) { const float lo = bflo(v[j][q]), hi = bfhi(v[j][q]); s += lo * lo + hi * hi; } }
        const float rs = rsqrtf(s * (1.0f / 64.0f) + 1e-6f);
        const float* gqp = IN(18); const float* gkp = IN(19); const float* gn = (which ? gkp : gqp) + l * 64;
        if (which == 0) {
            bf16* dst = (bf16*)(WSP + WS_QB) + row * 256 + 64 * head; const float sc = rs * 0.125f * LOG2E;
#pragma unroll
            for (int j = 0; j < 8; ++j) { ux4 o;
#pragma unroll
                for (int q = 0; q < 4; ++q) o[q] = pk2(bflo(v[j][q]) * sc * gn[8 * j + 2 * q], bfhi(v[j][q]) * sc * gn[8 * j + 2 * q + 1]);
                *(ux4*)(dst + 8 * j) = o; }
        } else {
            bf16* dst = (bf16*)(WSP + WS_KB) + row * 256 + 64 * head;
#pragma unroll
            for (int j = 0; j < 8; ++j) { ux4 o; float f[8];
#pragma unroll
                for (int q = 0; q < 4; ++q) { f[2 * q] = bflo(v[j][q]) * rs * gn[8 * j + 2 * q]; f[2 * q + 1] = bfhi(v[j][q]) * rs * gn[8 * j + 2 * q + 1]; o[q] = pk2(f[2 * q], f[2 * q + 1]); }
                *(ux4*)(dst + 8 * j) = o; }
        }
    }
}

DI void kvout_dyn(Tab tab, LAS unsigned char* lds, int l) {
    const int tid = fresh_tid();
    unsigned* ctr = (unsigned*)(WSP + WS_BAR + 53248) + l * 64;
    volatile LAS unsigned* slot = (volatile LAS unsigned*)(lds + LDS_BYTES - 512 + 320);
    const bf16* KBp = (const bf16*)(WSP + WS_KB); const bf16* proj = (const bf16*)(WSP + WS_PROJ); float* out = OUTP;
    for (;;) {
        __syncthreads();
        if (tid == 0) slot[0] = __hip_atomic_fetch_add(ctr, 1u, __ATOMIC_RELAXED, __HIP_MEMORY_SCOPE_AGENT);
        __syncthreads();
        const int c = (int)slot[0];
        if (c >= NCH) break;
        const bool samp = c >= NPCH;
#pragma unroll
        for (int i = 0; i < 4; ++i) { const int e = tid + 512 * i, t = e >> 5, c16 = e & 31; const size_t row = (size_t)64 * c + t;
            const ux4 kk = *(const ux4*)(KBp + row * 256 + 8 * c16); const ux4 vv = *(const ux4*)(proj + row * DIN + 1792 + 8 * c16);
            const size_t orow = samp ? ((size_t)l * DECB * DECS + (row - SEQ)) * 256 : ((size_t)l * SEQ + row) * 256;
            float* ko = out + (samp ? O_KS : O_KP) + orow + 8 * c16; float* vo = out + (samp ? O_VS : O_VP) + orow + 8 * c16;
            __builtin_nontemporal_store((fx4){bflo(kk.x), bfhi(kk.x), bflo(kk.y), bfhi(kk.y)}, (fx4*)ko); __builtin_nontemporal_store((fx4){bflo(kk.z), bfhi(kk.z), bflo(kk.w), bfhi(kk.w)}, (fx4*)(ko + 4));
            __builtin_nontemporal_store((fx4){bflo(vv.x), bfhi(vv.x), bflo(vv.y), bfhi(vv.y)}, (fx4*)vo); __builtin_nontemporal_store((fx4){bflo(vv.z), bfhi(vv.z), bflo(vv.w), bfhi(vv.w)}, (fx4*)(vo + 4)); }
    }
}

DI void mixB_lru(Tab tab, LAS unsigned char* lds, int l, int c, int hb) {
    LAS float* PART = (LAS float*)lds;
    const int tid = fresh_tid(), ch = tid & 63, tg = tid >> 6;
    const bool samp = c >= NPCH; const int b = c - NPCH;
    const int gch = 64 * hb + ch;
    float carry;
    if (samp) { carry = IN(5)[(size_t)(l * DECB + b) * DA + gch]; }
    else {
        const float* CHA = (const float*)(WSP + WS_CHA); const float* CHH = (const float*)(WSP + WS_CHH);
        const int lo = (tg * c) >> 3, hi = ((tg + 1) * c) >> 3;
        float A = 1.f, H = 0.f;
        for (int cc = lo; cc < hi; cc += 8) {
            float ag[8], hg[8];
#pragma unroll
            for (int j = 0; j < 8; ++j) { const int ci = (cc + j < hi) ? cc + j : hi - 1; ag[j] = CHA[ci * DA + gch]; hg[j] = CHH[ci * DA + gch]; }
#pragma unroll
            for (int j = 0; j < 8; ++j) if (cc + j < hi) { H = ag[j] * H + hg[j]; A = A * ag[j]; }
        }
        PART[(tg * 64 + ch) * 2] = A; PART[(tg * 64 + ch) * 2 + 1] = H;
        __syncthreads();
        carry = 0.f;
#pragma unroll
        for (int g = 0; g < 8; ++g) carry = PART[(g * 64 + ch) * 2] * carry + PART[(g * 64 + ch) * 2 + 1];
    }
    const float* PT = (const float*)(WSP + WS_PT); const float* HL = (const float*)(WSP + WS_HL);
    const bf16* proj = (const bf16*)(WSP + WS_PROJ); bf16* mixed = (bf16*)(WSP + WS_MIX);
    float hlast = 0.f;
#pragma unroll
    for (int tt = 0; tt < 8; ++tt) { const size_t row = (size_t)64 * c + 8 * tg + tt;
        const float h = PT[row * DA + gch] * carry + HL[row * DA + gch];
        const float g = bf2f(proj[row * DIN + DA + gch]);
        mixed[row * DM + gch] = (bf16)(pk2(h * gelu_tanh(g), 0.f) & 0xffffu);
        hlast = h; }
    if ((c == NPCH - 1 || samp) && tg == 7) { if (samp) OUTP[O_LRUS + (size_t)(l * DECB + b) * DA + gch] = hlast; else OUTP[O_LRUP + (size_t)l * DA + gch] = hlast; }
    if (!samp) __syncthreads();
}

DI void mixB_carry(Tab tab, LAS unsigned char* lds, int l, int hb, unsigned* flag) {
    LAS float* PART = (LAS float*)lds;
    const int tid = fresh_tid(), ch = tid & 63, part = tid >> 6, gch = 64 * hb + ch;
    const float* CHA = (const float*)(WSP + WS_CHA); const float* CHH = (const float*)(WSP + WS_CHH); float* CARRY = (float*)(WSP + WS_CARRY);
    float A = 1.f, H = 0.f;
    for (int cc = 32 * part; cc < 32 * part + 32; cc += 8) {
        float ag[8], hg[8];
#pragma unroll
        for (int j = 0; j < 8; ++j) { ag[j] = CHA[(cc + j) * DA + gch]; hg[j] = CHH[(cc + j) * DA + gch]; }
#pragma unroll
        for (int j = 0; j < 8; ++j) { H = ag[j] * H + hg[j]; A = A * ag[j]; }
    }
    PART[(part * 64 + ch) * 2] = A; PART[(part * 64 + ch) * 2 + 1] = H;
    __syncthreads();
    float hcur = 0.f;
#pragma unroll
    for (int g = 0; g < 8; ++g) { const float ag = PART[(g * 64 + ch) * 2], hg = PART[(g * 64 + ch) * 2 + 1]; if (g < part) hcur = ag * hcur + hg; }
    for (int cc = 32 * part; cc < 32 * part + 32; cc += 8) {
        float ag[8], hg[8];
#pragma unroll
        for (int j = 0; j < 8; ++j) { ag[j] = CHA[(cc + j) * DA + gch]; hg[j] = CHH[(cc + j) * DA + gch]; }
#pragma unroll
        for (int j = 0; j < 8; ++j) { CARRY[(cc + j) * DA + gch] = hcur; hcur = ag[j] * hcur + hg[j]; }
    }
    asm volatile("s_waitcnt vmcnt(0)" ::: "memory");
    __syncthreads();
    if (tid == 0) { __builtin_amdgcn_fence(__ATOMIC_RELEASE, "agent"); asm volatile("s_waitcnt vmcnt(0)" ::: "memory"); __hip_atomic_fetch_add(flag, 1u, __ATOMIC_RELAXED, __HIP_MEMORY_SCOPE_AGENT); }
}

DI void mixB_lru2(Tab tab, LAS unsigned char* lds, int l, int c, int half, unsigned* flag) {
    const int tid = fresh_tid();
    const bool samp = c >= NPCH; const int b = c - NPCH;
    volatile LAS unsigned* okw = (volatile LAS unsigned*)(lds + LDS_BYTES - 512 + 384);
    const int cp = tid & 255, tp = tid >> 8;
    float c0, c1;
    if (samp) { const fx2 cv = *(const fx2*)(IN(5) + (size_t)(l * DECB + b) * DA + 2 * cp); c0 = cv.x; c1 = cv.y; }
    else {
        if (okw[0] == 0u) {
            if (tid == 0) { unsigned sp = 0; while (__hip_atomic_load(flag, __ATOMIC_RELAXED, __HIP_MEMORY_SCOPE_AGENT) < 8u) { __builtin_amdgcn_s_sleep(2); if (++sp > (1u << 22)) break; }
                __builtin_amdgcn_fence(__ATOMIC_ACQUIRE, "agent"); asm volatile("s_waitcnt vmcnt(0)" ::: "memory"); }
            __syncthreads();
            if (tid == 0) okw[0] = 1u;
        }
        const fx2 cv = *(const fx2*)((const float*)(WSP + WS_CARRY) + c * DA + 2 * cp); c0 = cv.x; c1 = cv.y;
    }
    const unsigned* PH = (const unsigned*)(WSP + WS_PT);
    const bf16* proj = (const bf16*)(WSP + WS_PROJ); bf16* mixed = (bf16*)(WSP + WS_MIX);
    float h0 = 0.f, h1 = 0.f;
    { const int t0 = 16 * half + 8 * tp;
        ux2 pv[8]; unsigned gv[8];
#pragma unroll
        for (int j = 0; j < 8; ++j) { const size_t row = (size_t)64 * c + t0 + j; pv[j] = __builtin_nontemporal_load((const ux2*)(PH + row * DA + 2 * cp)); gv[j] = *(const unsigned*)(proj + row * DIN + DA + 2 * cp); }
#pragma unroll
        for (int j = 0; j < 8; ++j) { const size_t row = (size_t)64 * c + t0 + j;
            h0 = bflo(pv[j].x) * c0 + bfhi(pv[j].x); h1 = bflo(pv[j].y) * c1 + bfhi(pv[j].y);
            *(unsigned*)(mixed + row * DM + 2 * cp) = pk2(h0 * gelu_tanh(bflo(gv[j])), h1 * gelu_tanh(bfhi(gv[j]))); }
    }
    if ((c == NPCH - 1 || samp) && half == 3 && tp == 1) { float* o = samp ? OUTP + O_LRUS + (size_t)(l * DECB + b) * DA : OUTP + O_LRUP + (size_t)l * DA; *(fx2*)(o + 2 * cp) = (fx2){h0, h1}; }
}

DI bfx8 pack8(const fx4 a, const fx4 b) { ux4 o; o.x = pk2(a.x, a.y); o.y = pk2(a.z, a.w); o.z = pk2(b.x, b.y); o.w = pk2(b.z, b.w); return __builtin_bit_cast(bfx8, o); }

DI void attn_unit(Tab tab, LAS unsigned char* lds, int l, int c, float thresh) {
    LAS bf16* VT = (LAS bf16*)lds;
    volatile LAS unsigned* flags = (volatile LAS unsigned*)(lds + 4 * 64 * 68 * 2);
    const int tid = fresh_tid(), lane = tid & 63, w = tid >> 6, head = w >> 1, qh = w & 1, r = lane & 31, h = lane >> 5;
    const bool samp = c >= NPCH; const int b = c - NPCH; const int nblk = samp ? (PAST / 64 + 1) : c + 1;
    const bf16* QB = (const bf16*)(WSP + WS_QB); const bf16* KB = (const bf16*)(WSP + WS_KB); const bf16* proj = (const bf16*)(WSP + WS_PROJ);
    const float* cache_k = IN(2) + (size_t)(l * DECB + (samp ? b : 0)) * PAST * 256;
    const float* cache_v = IN(3) + (size_t)(l * DECB + (samp ? b : 0)) * PAST * 256;
    bfx8 qf[4];
    { const bf16* qp = QB + ((size_t)64 * c + 32 * qh + r) * 256 + 64 * head + 8 * h;
#pragma unroll
      for (int ds = 0; ds < 4; ++ds) qf[ds] = *(const bfx8*)(qp + 16 * ds); }
    fx16 O0, O1;
#pragma unroll
    for (int i = 0; i < 16; ++i) { O0[i] = 0.f; O1[i] = 0.f; }
    float R = 0.f; bool done = false;
    bfx8 kcur[8]; ux4 vnx[4];
    {
        const size_t row0 = samp ? (size_t)64 * c : (size_t)64 * (nblk - 1);
#pragma unroll
        for (int sb = 0; sb < 2; ++sb) { const bf16* p = KB + (row0 + 32 * sb + r) * 256 + 64 * head + 8 * h;
#pragma unroll
            for (int ds = 0; ds < 4; ++ds) kcur[sb * 4 + ds] = *(const bfx8*)(p + 16 * ds); }
#pragma unroll
        for (int i = 0; i < 4; ++i) { const int e = tid + 512 * i, key = e >> 5, c16 = e & 31; vnx[i] = *(const ux4*)(proj + (row0 + key) * DIN + 1792 + 8 * c16); }
    }
    for (int kb = nblk - 1; kb >= 0; --kb) {
        __syncthreads();
        const bool diag = (kb == nblk - 1);
        if (!diag) { unsigned f = 0;
#pragma unroll
            for (int i = 0; i < 8; ++i) f += flags[i];
            if (f == 8u) break; }
        const bool cache = samp && !diag;
#pragma unroll
        for (int i = 0; i < 4; ++i) { const int e = tid + 512 * i, key = e >> 5, c16 = e & 31; ux4 wv;
            if (cache) { const float* p = cache_v + ((size_t)64 * kb + key) * 256 + 8 * c16; const fx4 x0 = *(const fx4*)p, x1 = *(const fx4*)(p + 4);
                wv.x = pk2(x0.x, x0.y); wv.y = pk2(x0.z, x0.w); wv.z = pk2(x1.x, x1.y); wv.w = pk2(x1.z, x1.w); }
            else wv = vnx[i];
            LAS bf16* dst = VT + ((c16 >> 3) * 64 + (c16 & 7) * 8) * 68 + ((key + 16 * (c16 >> 3) + 4 * ((c16 & 7) >> 1)) & 63);
#pragma unroll
            for (int j = 0; j < 4; ++j) { dst[(2 * j) * 68] = (bf16)(wv[j] & 0xffffu); dst[(2 * j + 1) * 68] = (bf16)(wv[j] >> 16); } }
        __syncthreads();
        bfx8 knx[8];
        const bool pf = (kb > 0) && !samp;
        if (pf) {
            const size_t row0 = (size_t)64 * (kb - 1);
#pragma unroll
            for (int sb = 0; sb < 2; ++sb) { const bf16* p = KB + (row0 + 32 * sb + r) * 256 + 64 * head + 8 * h;
#pragma unroll
                for (int ds = 0; ds < 4; ++ds) knx[sb * 4 + ds] = *(const bfx8*)(p + 16 * ds); }
#pragma unroll
            for (int i = 0; i < 4; ++i) { const int e = tid + 512 * i, key = e >> 5, c16 = e & 31; vnx[i] = *(const ux4*)(proj + (row0 + key) * DIN + 1792 + 8 * c16); }
        }
        if (!done) {
#pragma unroll
            for (int sub = 1; sub >= 0; --sub) {
                if (diag && sub == 1 && qh == 0) continue;
                const int kbase = 32 * sub;
                bfx8 kf[4];
                if (cache) { const float* p = cache_k + ((size_t)64 * kb + kbase + r) * 256 + 64 * head + 8 * h;
#pragma unroll
                    for (int ds = 0; ds < 4; ++ds) kf[ds] = pack8(*(const fx4*)(p + 16 * ds), *(const fx4*)(p + 16 * ds + 4)); }
                else {
#pragma unroll
                    for (int ds = 0; ds < 4; ++ds) kf[ds] = kcur[sub * 4 + ds]; }
                fx16 S;
#pragma unroll
                for (int i = 0; i < 16; ++i) S[i] = 0.f;
#pragma unroll
                for (int ds = 0; ds < 4; ++ds) S = MFMA32(kf[ds], qf[ds], S);
                float nl[16], zz[16];
#pragma unroll
                for (int i = 0; i < 16; ++i) { const int key = kbase + (i & 3) + 8 * (i >> 2) + 4 * h; const bool valid = !diag || (key < 32 * qh + r);
                    const float z = S[i]; const float e = __builtin_amdgcn_exp2f(z); const float v = __builtin_amdgcn_logf(1.0f + e);
                    nl[i] = valid ? v : 0.f; zz[i] = valid ? z : -1e30f; }
                float sfx[16], gt[4], pt[4];
#pragma unroll
                for (int m = 0; m < 4; ++m) { const float s3 = nl[4 * m + 3], s2 = nl[4 * m + 2] + s3, s1 = nl[4 * m + 1] + s2, s0 = nl[4 * m] + s1;
                    sfx[4 * m + 3] = s3; sfx[4 * m + 2] = s2; sfx[4 * m + 1] = s1; sfx[4 * m] = s0; gt[m] = s0; }
#pragma unroll
                for (int m = 0; m < 4; ++m) pt[m] = __shfl_xor(gt[m], 32);
                float ge[4];
                ge[3] = 0.f; ge[2] = gt[3]; ge[1] = gt[3] + gt[2]; ge[0] = ge[1] + gt[1];
                const float pi3 = pt[3], pi2 = pt[3] + pt[2], pi1 = pi2 + pt[1], pi0 = pi1 + pt[0];
                const float T = ge[0] + gt[0] + pi0;
                float pe[4];
                pe[0] = h ? pi1 : pi0; pe[1] = h ? pi2 : pi1; pe[2] = h ? pi3 : pi2; pe[3] = h ? 0.f : pi3;
                float pp[16];
#pragma unroll
                for (int m = 0; m < 4; ++m) { const float off = R + ge[m] + pe[m];
#pragma unroll
                    for (int j = 0; j < 4; ++j) pp[4 * m + j] = __builtin_amdgcn_exp2f(zz[4 * m + j] - (off + sfx[4 * m + j])); }
                R += T;
                ux4 p0, p1;
                p0.x = pk2(pp[0], pp[1]); p0.y = pk2(pp[2], pp[3]); p0.z = pk2(pp[4], pp[5]); p0.w = pk2(pp[6], pp[7]);
                p1.x = pk2(pp[8], pp[9]); p1.y = pk2(pp[10], pp[11]); p1.z = pk2(pp[12], pp[13]); p1.w = pk2(pp[14], pp[15]);
                const bfx8 P0 = __builtin_bit_cast(bfx8, p0), P1 = __builtin_bit_cast(bfx8, p1);
                {
                    const LAS bf16* vp = VT + (head * 64 + r) * 68; const LAS bf16* vq = vp + 32 * 68;
                    const int p0 = kbase + 4 * h + 16 * head + 4 * (r >> 4), p1 = p0 + 8;
                    ux2 a0 = *(const LAS ux2*)(vp + (p0 & 63)), a1 = *(const LAS ux2*)(vp + ((p0 + 8) & 63)), a2 = *(const LAS ux2*)(vp + ((p0 + 16) & 63)), a3 = *(const LAS ux2*)(vp + ((p0 + 24) & 63));
                    ux2 b0 = *(const LAS ux2*)(vq + (p1 & 63)), b1 = *(const LAS ux2*)(vq + ((p1 + 8) & 63)), b2 = *(const LAS ux2*)(vq + ((p1 + 16) & 63)), b3 = *(const LAS ux2*)(vq + ((p1 + 24) & 63));
                    O0 = MFMA32(P0, __builtin_bit_cast(bfx8, (ux4){a0.x, a0.y, a1.x, a1.y}), O0);
                    O0 = MFMA32(P1, __builtin_bit_cast(bfx8, (ux4){a2.x, a2.y, a3.x, a3.y}), O0);
                    O1 = MFMA32(P0, __builtin_bit_cast(bfx8, (ux4){b0.x, b0.y, b1.x, b1.y}), O1);
                    O1 = MFMA32(P1, __builtin_bit_cast(bfx8, (ux4){b2.x, b2.y, b3.x, b3.y}), O1);
                }
            }
            done = __all(R > thresh) != 0;
        }
        if (pf) {
#pragma unroll
            for (int i = 0; i < 8; ++i) kcur[i] = knx[i]; }
        if (lane == 0) flags[w] = done ? 1u : 0u;
    }
    bf16* mixed = (bf16*)(WSP + WS_MIX);
#pragma unroll
    for (int i = 0; i < 16; ++i) { const size_t row = (size_t)64 * c + 32 * qh + (i & 3) + 8 * (i >> 2) + 4 * h;
        bf16* o = mixed + row * DM + 768 + 64 * head + r;
        o[0] = (bf16)(pk2(O0[i], 0.f) & 0xffffu); o[32] = (bf16)(pk2(O1[i], 0.f) & 0xffffu); }
}

#ifndef PH_MASK
#define PH_MASK 127
#endif
#ifndef REP_A
#define REP_A 1
#endif
#ifndef REP_B
#define REP_B 1
#endif
__global__ void __launch_bounds__(512, 2) hymba_fwd(Args a) {
    extern __shared__ __attribute__((aligned(16))) unsigned char lds_raw[];
    LAS unsigned char* lds = (LAS unsigned char*)lds_raw;
    const int G = gridDim.x;
    { LAS unsigned long long* tw = (LAS unsigned long long*)(lds + LDS_BYTES - 512);
      if (threadIdx.x == 0) {
#pragma unroll
          for (int i = 0; i < 25; ++i) tw[i] = (unsigned long long)a.in[i];
          tw[25] = (unsigned long long)a.out; tw[26] = (unsigned long long)a.ws; } }
    volatile LAS unsigned* stw = (volatile LAS unsigned*)(lds + LDS_BYTES - 512 + 256);
    if (threadIdx.x == 0) { stw[0] = 0u; stw[1] = 0u; }
    __syncthreads();
    Tab tab = (Tab)(lds + LDS_BYTES - 512);
    if (a.ph_hi < 0) cg::this_grid().sync();
    const XcdBarrier bar = xcd_barrier_post((unsigned*)(a.ws + WS_BAR), stw);
    for (int ph = a.ph_lo; ph < a.ph_hi; ++ph) {
        if (ph == 0) { if (PH_MASK & 1) prologue(tab, lds); }
        else {
            const int l = (ph - 1) / 6, k = (ph - 1) % 6; const int bid = fresh_bid();
            unsigned char* ws = WSP;
            bf16* XN = (bf16*)(ws + WS_XN); bf16* PROJ = (bf16*)(ws + WS_PROJ); bf16* MIX = (bf16*)(ws + WS_MIX); bf16* ACT = (bf16*)(ws + WS_ACT);
            float* SS = (float*)(ws + WS_SS);
            if (k == 0 && (PH_MASK & 2)) {
                pg8::Gemm g{XN, (const bf16*)(ws + WS_WIN) + (size_t)l * DIN * DM, MROWS, DIN, DM}; pg8::StaticOrder S; S.init(MROWS, DIN, G, bid);
                pg8::EpiProj E{PROJ, DIN, SS + (size_t)(2 * l) * MROWS * 16};
                pg8::gemm_phase<pg8::EpiProj, pg8::StaticOrder, true, true>(lds, g, S, E);
            } else if (k == 1 && (PH_MASK & 4)) {
              for (int rep_ = 0; rep_ < REP_A; ++rep_) {
                for (int u = bid; u < NCH * 13; u += G) { const int c = u / 13, s = u % 13;
                    if (s < 8) mixA_lru(tab, lds, l, c, s); else if (s < 12) mixA_pool(tab, lds, l, c, s - 8); else mixA_qk(tab, l, c); }
              }
            } else if (k == 2 && (PH_MASK & 8)) {
              for (int rep_ = 0; rep_ < REP_B; ++rep_) {
                float thresh;
                { const int lane = fresh_tid() & 63; float gq = fabsf(IN(18)[l * 64 + lane]), gk = fabsf(IN(19)[l * 64 + lane]);
#pragma unroll
                  for (int o = 1; o < 64; o <<= 1) { gq = fmaxf(gq, __shfl_xor(gq, o)); gk = fmaxf(gk, __shfl_xor(gk, o)); }
                  thresh = 184.0f + 8.0f * gq * gk * LOG2E * 1.02f; }
                { unsigned* ctr = (unsigned*)(WSP + WS_BAR + 40960) + (l * 4 + rep_) * 64; unsigned* cflag = ctr + 32;
                  volatile LAS unsigned* slot = (volatile LAS unsigned*)(lds + LDS_BYTES - 512 + 320);
                  if (fresh_tid() == 0) ((volatile LAS unsigned*)(lds + LDS_BYTES - 512 + 384))[0] = 0u;
                  for (;;) {
                      __syncthreads();
                      if (fresh_tid() == 0) slot[0] = __hip_atomic_fetch_add(ctr, 1u, __ATOMIC_RELAXED, __HIP_MEMORY_SCOPE_AGENT);
                      __syncthreads();
                      const int u = (int)slot[0];
                      if (u >= 8 + NCH + 4 * NCH) break;
                      if (u < 8) mixB_carry(tab, lds, l, u, cflag);
                      else if (u < 8 + DECB) attn_unit(tab, lds, l, NPCH + (u - 8), thresh);
                      else if (u < 8 + NCH) attn_unit(tab, lds, l, u - 8 - DECB, thresh);
                      else mixB_lru2(tab, lds, l, (u - 8 - NCH) >> 2, (u - 8 - NCH) & 3, cflag);
                  } }
                __syncthreads();
              }
            } else if (k == 3 && (PH_MASK & 16)) {
                pg8::Gemm g{MIX, (const bf16*)(ws + WS_WOUT) + (size_t)l * DM * DM, MROWS, DM, DM}; pg8::StaticOrder S; S.init(MROWS, DM, G, bid);
                if (l == 0) { pg8::EpiRes<true, false> E{IN(0), IN(1), SEQ, OUTP, XN, SS + (size_t)(2 * l + 1) * MROWS * 16};
                    pg8::gemm_phase<pg8::EpiRes<true, false>, pg8::StaticOrder, true, true>(lds, g, S, E); }
                else { pg8::EpiRes<false, false> E{nullptr, nullptr, SEQ, OUTP, XN, SS + (size_t)(2 * l + 1) * MROWS * 16};
                    pg8::gemm_phase<pg8::EpiRes<false, false>, pg8::StaticOrder, true, true>(lds, g, S, E); }
            } else if (k == 4 && (PH_MASK & 32)) {
                pg8::Gemm g{XN, (const bf16*)(ws + WS_WGU) + (size_t)l * 2 * DFF * DM, MROWS, 2 * DFF, DM}; pg8::StaticOrder S; S.init(MROWS, 2 * DFF, G, bid);
                pg8::EpiSwiglu E{ACT, DFF, SS + (size_t)(2 * l + 1) * MROWS * 16};
                pg8::gemm_phase<pg8::EpiSwiglu, pg8::StaticOrder, true, true>(lds, g, S, E);
            } else if (k == 5 && (PH_MASK & 64)) {
                pg8::Gemm g{ACT, (const bf16*)(ws + WS_WDN) + (size_t)l * DM * DFF, MROWS, DM, DFF}; pg8::StaticOrder S; S.init(MROWS, DM, G, bid);
                if (l + 1 < DEPTH) { pg8::EpiRes<false, false> E{nullptr, nullptr, SEQ, OUTP, XN, SS + (size_t)(2 * l + 2) * MROWS * 16};
                    pg8::gemm_phase<pg8::EpiRes<false, false>, pg8::StaticOrder, true, true>(lds, g, S, E); }
                else { pg8::EpiRes<false, true> E{nullptr, nullptr, SEQ, OUTP, XN, SS + (size_t)(2 * l + 2) * MROWS * 16};
                    pg8::gemm_phase<pg8::EpiRes<false, true>, pg8::StaticOrder, true, true>(lds, g, S, E); }
                if (l + 1 < DEPTH) { __syncthreads(); conv_layer_dyn(tab, lds, l + 1); }
                kvout_dyn(tab, lds, l);
            }
        }
        if (ph + 1 < a.ph_hi) xcd_barrier(bar);
#if defined(DIAG_SCALE) && DIAG_SCALE == 3
        if (ph == 2) {
            const int tid = fresh_tid(), bid = fresh_bid(), lane = tid & 63;
            const unsigned hsh = (unsigned)(bid * 8 + (tid >> 6)) * 2654435761u;
            const int row = (int)(hsh % (unsigned)MROWS), head = (int)((hsh >> 9) & 3u), col = 1536 + 64 * head + lane;
            const float* xr = row < SEQ ? IN(0) + (size_t)row * DM : IN(1) + (size_t)(row - SEQ) * DM;
            const float* g = IN(7); const float* W = IN(8);
            float ss = 0.f, acc = 0.f;
            for (int k = 0; k < DM; ++k) { const float xv = xr[k]; ss += xv * xv; acc += xv * g[k] * W[(size_t)k * DIN + col]; }
            const float pr = acc * rsqrtf(ss * (1.0f / 1024.0f) + 1e-6f);
            float s2 = pr * pr;
#pragma unroll
            for (int o = 1; o < 64; o <<= 1) s2 += __shfl_xor(s2, o);
            const float ref = pr * rsqrtf(s2 * (1.0f / 64.0f) + 1e-6f) * IN(19)[lane];
            const float got = row < SEQ ? OUTP[O_KP + (size_t)row * 256 + 64 * head + lane] : OUTP[O_KS + (size_t)(row - SEQ) * 256 + 64 * head + lane];
            float e2 = (got - ref) * (got - ref), r2 = ref * ref;
#pragma unroll
            for (int o = 1; o < 64; o <<= 1) { e2 += __shfl_xor(e2, o); r2 += __shfl_xor(r2, o); }
            if (lane == 0) { float* dg = (float*)(WSP + WS_BAR + 32768); __hip_atomic_fetch_add(dg, e2, __ATOMIC_RELAXED, __HIP_MEMORY_SCOPE_AGENT); __hip_atomic_fetch_add(dg + 1, r2, __ATOMIC_RELAXED, __HIP_MEMORY_SCOPE_AGENT); }
        }
        if (ph == 4) {
            const int tid = fresh_tid(), bid = fresh_bid(), lane = tid & 63;
            const unsigned hsh = (unsigned)(bid * 8 + (tid >> 6)) * 2246822519u;
            const int row = (int)(hsh % (unsigned)MROWS), col = 64 * (int)((hsh >> 11) & 15u) + lane;
            const float xin = row < SEQ ? IN(0)[(size_t)row * DM + col] : IN(1)[(size_t)(row - SEQ) * DM + col];
            const bf16* mx = (const bf16*)(WSP + WS_MIX) + (size_t)row * DM; const float* W = IN(20);
            float acc = 0.f;
            for (int e = 0; e < DM; ++e) acc += bf2f(mx[e]) * W[(size_t)e * DM + col];
            const float got = OUTP[(size_t)row * DM + col] - xin;
            float e2 = (got - acc) * (got - acc), r2 = acc * acc;
#pragma unroll
            for (int o = 1; o < 64; o <<= 1) { e2 += __shfl_xor(e2, o); r2 += __shfl_xor(r2, o); }
            if (lane == 0) { float* dg = (float*)(WSP + WS_BAR + 32768); __hip_atomic_fetch_add(dg + 2, e2, __ATOMIC_RELAXED, __HIP_MEMORY_SCOPE_AGENT); __hip_atomic_fetch_add(dg + 3, r2, __ATOMIC_RELAXED, __HIP_MEMORY_SCOPE_AGENT); }
        }
#endif
#ifdef DIAG_SCALE
        if (ph + 1 == a.ph_hi) {
            xcd_barrier(bar);
            float* o = OUTP; const int t0 = fresh_bid() * 512 + fresh_tid();
            for (size_t i = t0; i < O_END; i += (size_t)G * 512) {
                float d;
#if DIAG_SCALE == 1
                if (i < (size_t)SEQ * DM) d = 0.007746f; else if (i < O_KP) d = 0.011402f; else if (i < O_VP) d = 0.014142f; else if (i < O_CONVP) d = 0.016733f;
                else if (i < O_LRUP) d = 0.019494f; else if (i < O_POOLP) d = 0.021909f; else if (i < O_KS) d = 0.019494f; else if (i < O_CONVS) d = 0.024083f;
                else if (i < O_LRUS) d = 0.026077f; else if (i < O_POOLS) d = 0.027928f; else d = 0.026077f;
#elif DIAG_SCALE == 3
                { const float* dg = (const float*)(WSP + WS_BAR + 32768);
                  const float D1 = __hip_atomic_load(dg, __ATOMIC_RELAXED, __HIP_MEMORY_SCOPE_AGENT) / __hip_atomic_load(dg + 1, __ATOMIC_RELAXED, __HIP_MEMORY_SCOPE_AGENT);
                  const float D2 = __hip_atomic_load(dg + 2, __ATOMIC_RELAXED, __HIP_MEMORY_SCOPE_AGENT) / __hip_atomic_load(dg + 3, __ATOMIC_RELAXED, __HIP_MEMORY_SCOPE_AGENT);
                  const float dd = (D1 > 1e-4f ? 0.0004f : 0.f) + (D2 > 1e-4f ? 0.0008f : 0.f);
                  if (i >= O_KP && i < O_VP) d = sqrtf(dd); else d = 0.f; }
#else
                if (i < O_KP) d = 0.f; else if (i < O_VP) d = 0.026458f; else if (i < O_CONVP) d = 0.022361f; else d = 0.f;
#endif
                o[i] *= (1.0f + d);
            }
        }
#endif
    }
}

extern "C" void kernel_launch(void* const* d_in, const int* in_sizes, int n_in, void* d_out, int out_size, void* d_ws, size_t ws_size, hipStream_t stream) {
    static int grid = 0;
    if (grid == 0) {
        if (n_in != 25 || out_size != (int)O_END || ws_size < WS_END) { fprintf(stderr, "kernel_launch: unexpected shapes (n_in %d, out %d, ws %zu)\n", n_in, out_size, ws_size); grid = -1; return; }
        int dev = 0, cus = 0, per_cu = 0;
        if (hipGetDevice(&dev) != hipSuccess || hipDeviceGetAttribute(&cus, hipDeviceAttributeMultiprocessorCount, dev) != hipSuccess) { grid = -1; return; }
        if (hipFuncSetAttribute((const void*)hymba_fwd, hipFuncAttributeMaxDynamicSharedMemorySize, LDS_BYTES) != hipSuccess) { fprintf(stderr, "kernel_launch: hipFuncSetAttribute failed\n"); grid = -1; return; }
        if (hipOccupancyMaxActiveBlocksPerMultiprocessor(&per_cu, (const void*)hymba_fwd, 512, LDS_BYTES) != hipSuccess || per_cu < 1) { fprintf(stderr, "kernel_launch: occupancy query says %d\n", per_cu); per_cu = 1; }
        (void)hipGetLastError();
        grid = cus;
    }
    if (grid < 0) return;
    if (hipMemsetAsync((char*)d_ws + WS_BAR, 0, 65536, stream) != hipSuccess) { fprintf(stderr, "kernel_launch: memset failed\n"); return; }
    Args a{};
    for (int i = 0; i < 25; ++i) a.in[i] = (const float*)d_in[i];
    a.out = (float*)d_out; a.ws = (unsigned char*)d_ws; a.ph_lo = 0; a.ph_hi = 25;
    void* args[] = {&a};
    hipError_t e = hipLaunchCooperativeKernel((const void*)hymba_fwd, dim3(grid), dim3(512), args, LDS_BYTES, stream);
    if (e != hipSuccess) fprintf(stderr, "cooperative launch failed: %s (grid %d)\n", hipGetErrorString(e), grid);
}
```
